# Optimizing an MI355X kernel written in HIP

```python
import jax
import jax.numpy as jnp
from jax import lax
import numpy as np

D_MODEL = 4096
BATCH = 2
SEQ = 4096
DEPTH = 2
DEC_BATCH = 4
DEC_SEQ = 2048
PAST_LEN = 128

HEAD_DIM = 128
MIX_WIDTH = D_MODEL
RET_HEADS = MIX_WIDTH // (2 * HEAD_DIM)
ATT_HEADS = MIX_WIDTH // (2 * HEAD_DIM)
RET_WIDTH = RET_HEADS * HEAD_DIM
ATT_WIDTH = ATT_HEADS * HEAD_DIM
IN_SPLITS = (RET_WIDTH, RET_WIDTH, RET_WIDTH, RET_WIDTH, ATT_WIDTH, ATT_WIDTH, ATT_WIDTH)
IN_COLS = sum(IN_SPLITS)
RET_CHUNK = 128
DILATED_BRANCHES = ((128, 1), (512, 4), (2048, 16))
D_FF = -(-8 * D_MODEL // (3 * 256)) * 256
PLE_DIM = 256
RMS_EPS = 1e-6
GN_EPS = 1e-5
NEG_BIG = -1e30

kernel_name = 'hybrid_retention_dilated_encoder'


def rms_norm(x, g):
    xf = x.astype(jnp.float32)
    y = xf * lax.rsqrt(jnp.mean(xf * xf, axis=-1, keepdims=True) + RMS_EPS)
    return (y * g.astype(jnp.float32)).astype(x.dtype)


def alibi_slopes(n):
    return jnp.asarray(2.0 ** (-8.0 * np.arange(1, n + 1) / n), jnp.float32)


def retention_direction(q, k, v, log_gamma, strict):
    b, l, h, dh = q.shape
    c = RET_CHUNK
    n = l // c
    dt = q.dtype
    qc = q.reshape(b, n, c, h, dh)
    kc = k.reshape(b, n, c, h, dh)
    vc = v.reshape(b, n, c, h, dh)
    pos = jnp.arange(c, dtype=jnp.float32)
    diff = pos[:, None] - pos[None, :]
    valid = (diff > 0) if strict else (diff >= 0)
    intra_decay = jnp.where(valid[None], jnp.exp(log_gamma[:, None, None] * jnp.maximum(diff, 0.0)[None]), 0.0).astype(dt)
    scores = jnp.einsum('bnihd,bnjhd->bnhij', qc, kc) * intra_decay[None, None]
    intra = jnp.einsum('bnhij,bnjhd->bnihd', scores, vc)
    zeta = jnp.exp(log_gamma[None, :] * (c - 1 - pos)[:, None]).astype(dt)
    kv = jnp.einsum('bnjhd,jh,bnjhe->nbhde', kc, zeta, vc)
    chunk_decay = jnp.exp(log_gamma * c).astype(dt)[None, :, None, None]

    def step(state, kv_n):
        return state * chunk_decay + kv_n, state

    _, prev = lax.scan(step, jnp.zeros_like(kv[0]), kv)
    xi = jnp.exp(log_gamma[None, :] * (pos + 1)[:, None]).astype(dt)
    cross = jnp.einsum('bnihd,nbhde,ih->bnihe', qc, prev, xi)
    return (intra + cross).reshape(b, l, h, dh)


def retention_mixer(q, k, v, g, log_decay, gn_gain):
    b, l, h, dh = q.shape
    k = k * (dh ** -0.5)
    ld = log_decay.astype(jnp.float32)
    fwd = retention_direction(q, k, v, ld[0], False)
    bwd = retention_direction(q[:, ::-1], k[:, ::-1], v[:, ::-1], ld[1], True)[:, ::-1]
    y = (fwd + bwd).astype(jnp.float32)
    mu = jnp.mean(y, axis=-1, keepdims=True)
    var = jnp.mean(jnp.square(y - mu), axis=-1, keepdims=True)
    y = ((y - mu) * lax.rsqrt(var + GN_EPS)).reshape(b, l, h * dh) * gn_gain.astype(jnp.float32)
    return (jax.nn.silu(g.astype(jnp.float32)) * y).astype(q.dtype)


def dilated_branch(q, k, v, slopes, dilation, half):
    b, l, h, dh = q.shape
    m = l // dilation
    xb = b * dilation

    def to_residue(t):
        return jnp.swapaxes(t.reshape(b, m, dilation, h, dh), 1, 2).reshape(xb, m, h, dh)

    qr, kr, vr = to_residue(q), to_residue(k), to_residue(v)
    w = half
    nb = -(-m // w)
    mp = nb * w
    qb = jnp.pad(qr, ((0, 0), (0, mp - m), (0, 0), (0, 0))).reshape(xb, nb, w, h, dh)
    kp = jnp.pad(kr, ((0, 0), (w, mp - m + w), (0, 0), (0, 0)))
    vp = jnp.pad(vr, ((0, 0), (w, mp - m + w), (0, 0), (0, 0)))
    key_idx = w * jnp.arange(nb)[:, None] + jnp.arange(3 * w)[None, :]
    kb = kp[:, key_idx]
    vb = vp[:, key_idx]
    s = jnp.einsum('xnihd,xnjhd->xnhij', qb, kb).astype(jnp.float32)
    rel = jnp.arange(3 * w)[None, :] - w - jnp.arange(w)[:, None]
    key_pos = key_idx - w
    in_range = (key_pos >= 0) & (key_pos < m)
    valid = (jnp.abs(rel) <= w)[None] & in_range[:, None, :]
    bias = -slopes[:, None, None] * (dilation * jnp.abs(rel)).astype(jnp.float32)[None]
    s = jnp.where(valid[None, :, None], s + bias[None, None], NEG_BIG)
    mx = jnp.max(s, axis=-1, keepdims=True)
    e = jnp.exp(s - mx)
    den = jnp.sum(e, axis=-1, keepdims=True)
    out = jnp.einsum('xnhij,xnjhd->xnihd', (e / den).astype(v.dtype), vb)
    lse = (mx + jnp.log(den))[..., 0]
    out = out.reshape(xb, mp, h, dh)[:, :m]
    lse = jnp.swapaxes(lse, 2, 3).reshape(xb, mp, h)[:, :m]
    out = jnp.swapaxes(out.reshape(b, dilation, m, h, dh), 1, 2).reshape(b, l, h, dh)
    lse = jnp.swapaxes(lse.reshape(b, dilation, m, h), 1, 2).reshape(b, l, h)
    return out, lse


def dilated_attention(q, k, v, q_gain, k_gain):
    q = rms_norm(q, q_gain) * (HEAD_DIM ** -0.5)
    k = rms_norm(k, k_gain)
    slopes = alibi_slopes(q.shape[2])
    outs, lses = [], []
    for window, dil in DILATED_BRANCHES:
        o, lse = dilated_branch(q, k, v, slopes, dil, window // (2 * dil))
        outs.append(o)
        lses.append(lse)
    wts = jax.nn.softmax(jnp.stack(lses, axis=0), axis=0)
    return jnp.einsum('rblh,rblhd->blhd', wts.astype(v.dtype), jnp.stack(outs, axis=0))


def encoder_layer(x, p_i, ln_mix, w_in, ret_log_decay, ret_gn, q_norm, k_norm, w_out,
                  ln_ffn, w_gate, w_up, w_down, ln_ple, w_ple_gate, w_ple_proj):
    b, l, _ = x.shape
    u = rms_norm(x, ln_mix)
    z = u @ w_in
    cuts = [int(c) for c in np.cumsum(IN_SPLITS)[:-1]]
    rq, rk, rv, rg, aq, ak, av = jnp.split(z, cuts, axis=-1)
    rh = lambda t: t.reshape(b, l, RET_HEADS, HEAD_DIM)
    ah = lambda t: t.reshape(b, l, ATT_HEADS, HEAD_DIM)
    ret = retention_mixer(rh(rq), rh(rk), rh(rv), rg, ret_log_decay, ret_gn)
    att = dilated_attention(ah(aq), ah(ak), ah(av), q_norm, k_norm).reshape(b, l, ATT_WIDTH)
    x = x + jnp.concatenate([ret, att], axis=-1) @ w_out
    f = rms_norm(x, ln_ffn)
    x = x + (jax.nn.silu(f @ w_gate) * (f @ w_up)) @ w_down
    e = rms_norm(x, ln_ple)
    x = x + jax.nn.sigmoid(e @ w_ple_gate) * (p_i @ w_ple_proj)
    return x


def run_trunk(x, p, ln_mix, w_in, ret_log_decay, ret_gn, q_norm, k_norm, w_out,
              ln_ffn, w_gate, w_up, w_down, ln_ple, w_ple_gate, w_ple_proj):
    for i in range(DEPTH):
        x = encoder_layer(x, p[i], ln_mix[i], w_in[i], ret_log_decay[i], ret_gn[i], q_norm[i], k_norm[i],
                          w_out[i], ln_ffn[i], w_gate[i], w_up[i], w_down[i], ln_ple[i], w_ple_gate[i],
                          w_ple_proj[i])
    return x


def setup_inputs(seed: int = 0) -> dict:
    key = jax.random.key(seed)
    ks = jax.random.split(key, 20)
    f32 = jnp.float32

    def normal(k, shape, scale=1.0):
        return scale * jax.random.normal(k, shape, f32)

    def gain(k, shape):
        return 1.0 + 0.02 * jax.random.normal(k, shape, f32)

    base_decay = jnp.asarray(np.log1p(-2.0 ** (-5.0 - np.arange(RET_HEADS))), f32)
    ret_log_decay = base_decay * (1.0 + 0.05 * jax.random.normal(ks[6], (DEPTH, 2, RET_HEADS), f32))
    return {
        'x_prompt': normal(ks[0], (BATCH, SEQ, D_MODEL)),
        'x_sample': normal(ks[1], (DEC_BATCH, DEC_SEQ, D_MODEL)),
        'p_prompt': normal(ks[2], (DEPTH, BATCH, SEQ, PLE_DIM)),
        'p_sample': normal(ks[3], (DEPTH, DEC_BATCH, DEC_SEQ, PLE_DIM)),
        'ln_mix': gain(ks[4], (DEPTH, D_MODEL)),
        'w_in': normal(ks[5], (DEPTH, D_MODEL, IN_COLS), D_MODEL ** -0.5),
        'ret_log_decay': ret_log_decay,
        'ret_gn': gain(ks[7], (DEPTH, RET_WIDTH)),
        'q_norm': gain(ks[8], (DEPTH, HEAD_DIM)),
        'k_norm': gain(ks[9], (DEPTH, HEAD_DIM)),
        'w_out': normal(ks[10], (DEPTH, MIX_WIDTH, D_MODEL), MIX_WIDTH ** -0.5),
        'ln_ffn': gain(ks[11], (DEPTH, D_MODEL)),
        'w_gate': normal(ks[12], (DEPTH, D_MODEL, D_FF), D_MODEL ** -0.5),
        'w_up': normal(ks[13], (DEPTH, D_MODEL, D_FF), D_MODEL ** -0.5),
        'w_down': normal(ks[14], (DEPTH, D_FF, D_MODEL), D_FF ** -0.5),
        'ln_ple': gain(ks[15], (DEPTH, D_MODEL)),
        'w_ple_gate': normal(ks[16], (DEPTH, D_MODEL, D_MODEL), D_MODEL ** -0.5),
        'w_ple_proj': normal(ks[17], (DEPTH, PLE_DIM, D_MODEL), PLE_DIM ** -0.5),
    }


def reference(x_prompt, x_sample, p_prompt, p_sample, ln_mix, w_in, ret_log_decay, ret_gn, q_norm,
              k_norm, w_out, ln_ffn, w_gate, w_up, w_down, ln_ple, w_ple_gate, w_ple_proj):
    y_prompt = run_trunk(x_prompt, p_prompt, ln_mix, w_in, ret_log_decay, ret_gn, q_norm, k_norm, w_out,
                         ln_ffn, w_gate, w_up, w_down, ln_ple, w_ple_gate, w_ple_proj)
    y_sample = run_trunk(x_sample, p_sample, ln_mix, w_in, ret_log_decay, ret_gn, q_norm, k_norm, w_out,
                         ln_ffn, w_gate, w_up, w_down, ln_ple, w_ple_gate, w_ple_proj)
    return (y_prompt, y_sample)
```

```cpp
#include <hip/hip_runtime.h>
#include <cstdio>
#include <cstdint>

__device__ __forceinline__ int opaque_tid() { int t = threadIdx.x; asm volatile("" : "+v"(t)); return t; }
template <class T> __device__ __forceinline__ T* opaque_ptr(T* p) { asm volatile("" : "+s"(p)); return p; }
namespace pg8 {
#define PG8_LAS __attribute__((address_space(3)))
typedef unsigned short bf16_t;
typedef short bf16x8 __attribute__((ext_vector_type(8)));
typedef float f32x4 __attribute__((ext_vector_type(4)));
typedef int i32x4 __attribute__((ext_vector_type(4)));
typedef unsigned u32x4 __attribute__((ext_vector_type(4)));
typedef unsigned u32x2 __attribute__((ext_vector_type(2)));
constexpr int BM = 256, BK = 64, HALF = 128, HTB = HALF * BK * 2, STAGE_BYTES = 8 * HTB, NXCD = 8, WGM = 8;

__host__ __device__ __forceinline__ int lds_byte(int r, int c) { const int st = (r >> 4) * 2 + (c >> 5), rr = r & 15, cc = c & 31, ob = rr * 64 + cc * 2; return st * 1024 + (ob ^ (((ob >> 9) & 1) << 5)); }
__host__ __device__ __forceinline__ void stage_rc(int b, int& R, int& C) { const int st = b / 1024, sb = b % 1024, swz = sb ^ (((sb >> 9) & 1) << 5); R = (st >> 1) * 16 + swz / 64; C = (st & 1) * 32 + (swz % 64) / 2; }
__host__ __device__ __forceinline__ int perm32(int rho) { const int n = rho >> 4, i = rho & 15; return 8 * (i >> 2) + 4 * n + (i & 3); }

struct Unit { int pm, pn; };
struct Gemm { const bf16_t* A; const bf16_t* Bt; int M, N, K; };

struct StaticOrder {
    int nM, nN, nwg, G, c, base, lim;
    __host__ __device__ void init(int M, int N, int G_, int c_) { nM = M / BM; nN = N / BM; nwg = nM * nN; G = G_; c = c_; base = 0; lim = nwg; }
    __host__ __device__ bool next(int i, Unit& u) const {
        const long L = (long)base + (long)i * G + c; if (L >= lim) return false;
        int wgid = (int)L; { const int q = nwg / NXCD, r = nwg % NXCD, xcd = wgid % NXCD, off = wgid / NXCD; wgid = (xcd < r ? xcd * (q + 1) : r * (q + 1) + (xcd - r) * q) + off; }
        const int nig = WGM * nN, gid = wgid / nig, fm = gid * WGM, gsz = (nM - fm) < WGM ? (nM - fm) : WGM;
        u.pm = fm + ((wgid % nig) % gsz); u.pn = (wgid % nig) / gsz; return true;
    }
    __device__ __forceinline__ void a_ready(const Unit&) const {}
    __device__ __forceinline__ void done(const Unit&) const {}
};

__device__ __forceinline__ unsigned cvt_pk_bf16(float lo, float hi) { unsigned r; asm volatile("v_cvt_pk_bf16_f32 %0, %1, %2" : "=v"(r) : "v"(lo), "v"(hi)); return r; }
__device__ __forceinline__ float fast_sigmoid(float x) { return __builtin_amdgcn_rcpf(1.0f + __expf(-x)); }

struct EpiStoreBf16 {
    static constexpr bool PERM = true, AFTER_DRAIN = false;
    bf16_t* O; int ldc;
    __device__ __forceinline__ void operator()(const f32x4 (&acc)[2][2][4][2], const Unit& u, int wr, int wc, int fr, int fq) const {
        const int row0 = u.pm * BM + wr * 64 + fr, col0 = u.pn * BM + wc * 32 + 8 * fq;
#pragma unroll
        for (int ai = 0; ai < 2; ++ai)
#pragma unroll
            for (int m = 0; m < 4; ++m) { bf16_t* rowp = O + (size_t)(row0 + ai * HALF + m * 16) * ldc + col0;
#pragma unroll
                for (int bj = 0; bj < 2; ++bj) { const f32x4 v0 = acc[ai][bj][m][0], v1 = acc[ai][bj][m][1];
                    u32x4 w; w.x = cvt_pk_bf16(v0[0], v0[1]); w.y = cvt_pk_bf16(v0[2], v0[3]); w.z = cvt_pk_bf16(v1[0], v1[1]); w.w = cvt_pk_bf16(v1[2], v1[3]);
                    *(u32x4*)(rowp + bj * HALF) = w; } }
    }
};
typedef unsigned long long u64_t;
__device__ __forceinline__ u64_t ss_fix(float ss) { return (u64_t)(ss * 1048576.0f + 0.5f); }
__device__ __forceinline__ float ss_rs(u64_t v) { return 1.0f / sqrtf((float)v * (1.0f / (1048576.0f * 4096.0f)) + 1e-6f); }
__device__ __forceinline__ float row_rs(const u64_t* SS, int row) { return ss_rs(SS[row]); }
struct EpiStoreHeads {
    static constexpr bool PERM = true, AFTER_DRAIN = false;
    bf16_t* O; int Mrows; const u64_t* SS; const float* qg; const float* kg; PG8_LAS float* T;
    __device__ __forceinline__ void operator()(const f32x4 (&acc)[2][2][4][2], const Unit& u, int wr, int wc, int fr, int fq) const {
        const int row0 = u.pm * BM + wr * 64 + fr, col0 = wc * 32 + 8 * fq;
        const bool qk = 2 * u.pn >= 48;
        float rsv[2][4];
        { u64_t ssv[2][4];
#pragma unroll
          for (int ai = 0; ai < 2; ++ai)
#pragma unroll
              for (int m = 0; m < 4; ++m) ssv[ai][m] = SS[row0 + ai * HALF + m * 16];
          __builtin_amdgcn_sched_barrier(0);
#pragma unroll
          for (int ai = 0; ai < 2; ++ai)
#pragma unroll
              for (int m = 0; m < 4; ++m) rsv[ai][m] = __builtin_amdgcn_rsqf((float)ssv[ai][m] * (1.0f / (1048576.0f * 4096.0f)) + 1e-6f); }
        if (qk) {
            float sp[2][4][2];
#pragma unroll
            for (int ai = 0; ai < 2; ++ai)
#pragma unroll
                for (int m = 0; m < 4; ++m) { const float rs = rsv[ai][m];
#pragma unroll
                    for (int bj = 0; bj < 2; ++bj) { const f32x4 v0 = acc[ai][bj][m][0] * rs, v1 = acc[ai][bj][m][1] * rs;
                        sp[ai][m][bj] = ((v0[0] * v0[0] + v0[1] * v0[1]) + (v0[2] * v0[2] + v0[3] * v0[3])) + ((v1[0] * v1[0] + v1[1] * v1[1]) + (v1[2] * v1[2] + v1[3] * v1[3])); } }
            float t1[2][4][2];
#pragma unroll
            for (int ai = 0; ai < 2; ++ai)
#pragma unroll
                for (int m = 0; m < 4; ++m)
#pragma unroll
                    for (int bj = 0; bj < 2; ++bj) t1[ai][m][bj] = __shfl_xor(sp[ai][m][bj], 16);
#pragma unroll
            for (int ai = 0; ai < 2; ++ai)
#pragma unroll
                for (int m = 0; m < 4; ++m)
#pragma unroll
                    for (int bj = 0; bj < 2; ++bj) sp[ai][m][bj] += t1[ai][m][bj];
#pragma unroll
            for (int ai = 0; ai < 2; ++ai)
#pragma unroll
                for (int m = 0; m < 4; ++m)
#pragma unroll
                    for (int bj = 0; bj < 2; ++bj) t1[ai][m][bj] = __shfl_xor(sp[ai][m][bj], 32);
            if (fq == 0) {
#pragma unroll
                for (int ai = 0; ai < 2; ++ai)
#pragma unroll
                    for (int m = 0; m < 4; ++m) { const int rt = ai * HALF + wr * 64 + m * 16 + fr;
#pragma unroll
                        for (int bj = 0; bj < 2; ++bj) T[(rt * 2 + bj) * 4 + wc] = sp[ai][m][bj] + t1[ai][m][bj]; } }
            asm volatile("s_waitcnt lgkmcnt(0)" ::: "memory"); __builtin_amdgcn_s_barrier(); asm volatile("" ::: "memory");
        }
        const bool isq = 2 * u.pn < 64;
        const float* gp = (isq ? qg : kg) + col0; const float sc = isq ? 0.08838834764831845f : 1.0f;
        f32x4 g0 = (f32x4){1.f, 1.f, 1.f, 1.f}, g1 = g0;
        if (qk) { g0 = *(const f32x4*)gp; g1 = *(const f32x4*)(gp + 4); }
#pragma unroll
        for (int ai = 0; ai < 2; ++ai)
#pragma unroll
            for (int m = 0; m < 4; ++m) { const int row = row0 + ai * HALF + m * 16; const float rs = rsv[ai][m]; const int rt = ai * HALF + wr * 64 + m * 16 + fr;
#pragma unroll
                for (int bj = 0; bj < 2; ++bj) { f32x4 v0 = acc[ai][bj][m][0] * rs, v1 = acc[ai][bj][m][1] * rs;
                    if (qk) { const f32x4 t = *(const PG8_LAS f32x4*)(T + (rt * 2 + bj) * 4);
                        const float rn = __builtin_amdgcn_rsqf(((t[0] + t[1]) + (t[2] + t[3])) * (1.f / 128.f) + 1e-6f) * sc;
                        v0 = (v0 * rn) * g0; v1 = (v1 * rn) * g1; }
                    u32x4 w; w.x = cvt_pk_bf16(v0[0], v0[1]); w.y = cvt_pk_bf16(v0[2], v0[3]); w.z = cvt_pk_bf16(v1[0], v1[1]); w.w = cvt_pk_bf16(v1[2], v1[3]);
                    const int pc = 2 * u.pn + bj, pl = pc + (pc >= 32 ? 16 : 0);
                    *(u32x4*)(O + ((size_t)pl * Mrows + row) * HALF + col0) = w; } }
    }
};
struct EpiStoreHeadsQ {
    static constexpr bool PERM = true, AFTER_DRAIN = false;
    bf16_t* O; int Mrows; const float* RA; const float* DB;
    __device__ __forceinline__ void operator()(const i32x4 (&acc)[2][2][4][2], const Unit& u, int wr, int wc, int fr, int fq) const {
        const int row0 = u.pm * BM + wr * 64 + fr, col0 = wc * 32 + 8 * fq, bcol = u.pn * BM + wc * 32 + 8 * fq;
        f32x4 db[2][2];
#pragma unroll
        for (int bj = 0; bj < 2; ++bj) { db[bj][0] = *(const f32x4*)(DB + bcol + bj * HALF); db[bj][1] = *(const f32x4*)(DB + bcol + bj * HALF + 4); }
        float rav[2][4];
#pragma unroll
        for (int ai = 0; ai < 2; ++ai)
#pragma unroll
            for (int m = 0; m < 4; ++m) rav[ai][m] = RA[row0 + ai * HALF + m * 16];
        __builtin_amdgcn_sched_barrier(0);
#pragma unroll
        for (int ai = 0; ai < 2; ++ai)
#pragma unroll
            for (int m = 0; m < 4; ++m) { const int row = row0 + ai * HALF + m * 16; const float ra = rav[ai][m];
#pragma unroll
                for (int bj = 0; bj < 2; ++bj) { float v[8];
#pragma unroll
                    for (int j = 0; j < 4; ++j) { v[j] = (float)acc[ai][bj][m][0][j] * ra * db[bj][0][j]; v[4 + j] = (float)acc[ai][bj][m][1][j] * ra * db[bj][1][j]; }
                    u32x4 w; w.x = cvt_pk_bf16(v[0], v[1]); w.y = cvt_pk_bf16(v[2], v[3]); w.z = cvt_pk_bf16(v[4], v[5]); w.w = cvt_pk_bf16(v[6], v[7]);
                    const int pc = 2 * u.pn + bj, pl = pc < 16 ? 32 + pc : 80 + pc;
                    *(u32x4*)(O + ((size_t)pl * Mrows + row) * HALF + col0) = w; } }
    }
};
__device__ __forceinline__ void unpack8(const u32x4 w, f32x4& a, f32x4& b) { a[0] = __uint_as_float(w.x << 16); a[1] = __uint_as_float(w.x & 0xffff0000u); a[2] = __uint_as_float(w.y << 16); a[3] = __uint_as_float(w.y & 0xffff0000u);
    b[0] = __uint_as_float(w.z << 16); b[1] = __uint_as_float(w.z & 0xffff0000u); b[2] = __uint_as_float(w.w << 16); b[3] = __uint_as_float(w.w & 0xffff0000u); }
struct EpiResAdd {
    static constexpr bool PERM = true, AFTER_DRAIN = false;
    bf16_t* XB; int ldc;
    __device__ __forceinline__ void operator()(const f32x4 (&acc)[2][2][4][2], const Unit& u, int wr, int wc, int fr, int fq) const {
        const int row0 = u.pm * BM + wr * 64 + fr, col0 = u.pn * BM + wc * 32 + 8 * fq;
        u32x4 xv[2][4][2];
#pragma unroll
        for (int ai = 0; ai < 2; ++ai)
#pragma unroll
            for (int m = 0; m < 4; ++m)
#pragma unroll
                for (int bj = 0; bj < 2; ++bj) xv[ai][m][bj] = *(const u32x4*)(XB + (size_t)(row0 + ai * HALF + m * 16) * ldc + col0 + bj * HALF);
#pragma unroll
        for (int ai = 0; ai < 2; ++ai) {
#pragma unroll
            for (int m = 0; m < 4; ++m) { const int row = row0 + ai * HALF + m * 16;
#pragma unroll
                for (int bj = 0; bj < 2; ++bj) { f32x4 v0, v1; unpack8(xv[ai][m][bj], v0, v1); v0 = v0 + acc[ai][bj][m][0]; v1 = v1 + acc[ai][bj][m][1];
                    u32x4 w; w.x = cvt_pk_bf16(v0[0], v0[1]); w.y = cvt_pk_bf16(v0[2], v0[3]); w.z = cvt_pk_bf16(v1[0], v1[1]); w.w = cvt_pk_bf16(v1[2], v1[3]);
                    *(u32x4*)(XB + (size_t)row * ldc + col0 + bj * HALF) = w; } }
            asm volatile("" ::: "memory"); }
    }
};
struct EpiSwiGLUQ {
    static constexpr bool PERM = true, AFTER_DRAIN = false;
    bf16_t* H; int ldh; const float* RA; const float* DB;
    __device__ __forceinline__ void operator()(const i32x4 (&acc)[2][2][4][2], const Unit& u, int wr, int wc, int fr, int fq) const {
        const int row0 = u.pm * BM + wr * 64 + fr, col0 = u.pn * HALF + wc * 32 + 8 * fq, brow = u.pn * BM + wc * 32 + 8 * fq;
        const f32x4 dg0 = *(const f32x4*)(DB + brow), dg1 = *(const f32x4*)(DB + brow + 4), du0 = *(const f32x4*)(DB + brow + HALF), du1 = *(const f32x4*)(DB + brow + HALF + 4);
        float rav[2][4];
#pragma unroll
        for (int ai = 0; ai < 2; ++ai)
#pragma unroll
            for (int m = 0; m < 4; ++m) rav[ai][m] = RA[row0 + ai * HALF + m * 16];
        __builtin_amdgcn_sched_barrier(0);
#pragma unroll
        for (int ai = 0; ai < 2; ++ai)
#pragma unroll
            for (int m = 0; m < 4; ++m) { const int row = row0 + ai * HALF + m * 16; const float ra = rav[ai][m]; bf16_t* rowp = H + (size_t)row * ldh + col0;
                float hv[8];
#pragma unroll
                for (int j = 0; j < 4; ++j) { const float g0 = (float)acc[ai][0][m][0][j] * ra * dg0[j], u0 = (float)acc[ai][1][m][0][j] * ra * du0[j]; hv[j] = g0 * fast_sigmoid(g0) * u0;
                    const float g1 = (float)acc[ai][0][m][1][j] * ra * dg1[j], u1 = (float)acc[ai][1][m][1][j] * ra * du1[j]; hv[4 + j] = g1 * fast_sigmoid(g1) * u1; }
                u32x4 w; w.x = cvt_pk_bf16(hv[0], hv[1]); w.y = cvt_pk_bf16(hv[2], hv[3]); w.z = cvt_pk_bf16(hv[4], hv[5]); w.w = cvt_pk_bf16(hv[6], hv[7]);
                *(u32x4*)rowp = w; }
    }
};
struct EpiSwiGLU {
    static constexpr bool PERM = true, AFTER_DRAIN = false;
    bf16_t* H; int ldh; const u64_t* SS;
    __device__ __forceinline__ void operator()(const f32x4 (&acc)[2][2][4][2], const Unit& u, int wr, int wc, int fr, int fq) const {
        const int row0 = u.pm * BM + wr * 64 + fr, col0 = u.pn * HALF + wc * 32 + 8 * fq;
#pragma unroll
        for (int ai = 0; ai < 2; ++ai)
#pragma unroll
            for (int m = 0; m < 4; ++m) { const int row = row0 + ai * HALF + m * 16; const float rs = row_rs(SS, row); bf16_t* rowp = H + (size_t)row * ldh + col0;
                float hv[8];
#pragma unroll
                for (int n = 0; n < 2; ++n)
#pragma unroll
                    for (int j = 0; j < 4; ++j) { const float g = acc[ai][0][m][n][j] * rs, up = acc[ai][1][m][n][j] * rs; hv[4 * n + j] = g * fast_sigmoid(g) * up; }
                u32x4 w; w.x = cvt_pk_bf16(hv[0], hv[1]); w.y = cvt_pk_bf16(hv[2], hv[3]); w.z = cvt_pk_bf16(hv[4], hv[5]); w.w = cvt_pk_bf16(hv[6], hv[7]);
                *(u32x4*)rowp = w; }
    }
};
template <bool Q> struct EpiPleT {
    static constexpr bool PERM = true, AFTER_DRAIN = false;
    const bf16_t* XBi; const bf16_t* PP; bf16_t* XBo; const u64_t* SS; const float* RA; const float* DB; u64_t* SSo; float* OUT; int ldc;
    template <class ACC> __device__ __forceinline__ void operator()(const ACC (&acc)[2][2][4][2], const Unit& u, int wr, int wc, int fr, int fq) const {
        const int row0 = u.pm * BM + wr * 64 + fr, col0 = u.pn * BM + wc * 32 + 8 * fq;
        f32x4 db[2][2];
        if constexpr (Q) {
#pragma unroll
            for (int bj = 0; bj < 2; ++bj) { db[bj][0] = *(const f32x4*)(DB + col0 + bj * HALF); db[bj][1] = *(const f32x4*)(DB + col0 + bj * HALF + 4); } }
#pragma unroll
        for (int ai = 0; ai < 2; ++ai)
#pragma unroll
          for (int mp = 0; mp < 2; ++mp) {
            u32x4 xv[2][2], pv[2][2]; float rsv[2];
#pragma unroll
            for (int mm = 0; mm < 2; ++mm) { const int row = row0 + ai * HALF + (2 * mp + mm) * 16; if constexpr (Q) rsv[mm] = RA[row]; else rsv[mm] = ss_rs(SS[row]);
#pragma unroll
                for (int bj = 0; bj < 2; ++bj) { xv[mm][bj] = *(const u32x4*)(XBi + (size_t)row * ldc + col0 + bj * HALF); pv[mm][bj] = *(const u32x4*)(PP + (size_t)row * ldc + col0 + bj * HALF); } }
#pragma unroll
            for (int mm = 0; mm < 2; ++mm) { const int m = 2 * mp + mm, row = row0 + ai * HALF + m * 16; float ss = 0.f; const float rs = rsv[mm];
#pragma unroll
                for (int bj = 0; bj < 2; ++bj) { f32x4 v0, v1, p0, p1; unpack8(xv[mm][bj], v0, v1); unpack8(pv[mm][bj], p0, p1); f32x4 a0, a1;
#pragma unroll
                    for (int j = 0; j < 4; ++j) { if constexpr (Q) { a0[j] = (float)acc[ai][bj][m][0][j] * rs * db[bj][0][j]; a1[j] = (float)acc[ai][bj][m][1][j] * rs * db[bj][1][j]; }
                                                  else { a0[j] = (float)acc[ai][bj][m][0][j] * rs; a1[j] = (float)acc[ai][bj][m][1][j] * rs; } }
#pragma unroll
                    for (int j = 0; j < 4; ++j) { v0[j] += fast_sigmoid(a0[j]) * p0[j]; v1[j] += fast_sigmoid(a1[j]) * p1[j]; }
                    if (OUT) { float* p = OUT + (size_t)row * ldc + col0 + bj * HALF; *(f32x4*)p = v0; *(f32x4*)(p + 4) = v1; }
                    else { u32x4 w; w.x = cvt_pk_bf16(v0[0], v0[1]); w.y = cvt_pk_bf16(v0[2], v0[3]); w.z = cvt_pk_bf16(v1[0], v1[1]); w.w = cvt_pk_bf16(v1[2], v1[3]);
                        *(u32x4*)(XBo + (size_t)row * ldc + col0 + bj * HALF) = w; unpack8(w, v0, v1);
                        ss += ((v0[0] * v0[0] + v0[1] * v0[1]) + (v0[2] * v0[2] + v0[3] * v0[3])) + ((v1[0] * v1[0] + v1[1] * v1[1]) + (v1[2] * v1[2] + v1[3] * v1[3])); } }
                if (!OUT) { ss += __shfl_xor(ss, 16); ss += __shfl_xor(ss, 32); if (fq == 0) atomicAdd(SSo + row, ss_fix(ss)); } }
            asm volatile("" ::: "memory"); }
    }
};

template <bool I8> struct AccT { typedef f32x4 type; }; template <> struct AccT<true> { typedef i32x4 type; };
template <class Epi, class Sched, bool ALIGN_EPI = false, bool SP2 = false, bool I8 = false>
__device__ __forceinline__ void gemm_phase(PG8_LAS unsigned char* lds, const Gemm g, const Sched& S, const Epi& E) {
    const int tid = opaque_tid(), wid = __builtin_amdgcn_readfirstlane(tid >> 6), lane = tid & 63, wr = wid >> 2, wc = wid & 3, fr = lane & 15, fq = lane >> 4;
    const int K = g.K, nt = K / BK;
    unsigned voffA[2], voffB[2];
#pragma unroll
    for (int i = 0; i < 2; ++i) { int R, C; stage_rc(tid * 16 + i * 8192, R, C); const int Rb = Epi::PERM ? ((R & ~31) + perm32(R & 31)) : R;
        voffA[i] = (unsigned)(R * K + C) * 2u; voffB[i] = (unsigned)(Rb * K + C) * 2u; }
    const size_t kstep = (size_t)(BK * 2);
    const size_t hstep = (size_t)HALF * K * 2;
    const size_t tstep = 2 * hstep;
    const unsigned ldsw = (unsigned)wid * 1024u;
    const int aoff = lds_byte(wr * 64 + fr, fq * 8), boff = lds_byte(wc * 32 + fr, fq * 8);
#define PG8_SA(b, h) (((b) * 2 + (h)) * HTB)
#define PG8_SB(b, h) ((4 + (b) * 2 + (h)) * HTB)
#define PG8_STAGE(bufoff, gbase, voff) do { _Pragma("unroll") for (int _i = 0; _i < 2; ++_i) \
        __builtin_amdgcn_global_load_lds((const unsigned*)((const char*)(gbase) + (voff)[_i]), (PG8_LAS unsigned*)(lds + (bufoff) + ldsw + _i * 8192), 16, 0, 0); } while (0)
#define PG8_LDA(dst, b, h) do { _Pragma("unroll") for (int m = 0; m < 4; ++m) _Pragma("unroll") for (int k = 0; k < 2; ++k) dst[m][k] = *(const PG8_LAS bf16x8*)(lds + PG8_SA(b, h) + aoff + m * 2048 + k * 1024); } while (0)
#define PG8_LDB(dst, b, h) do { _Pragma("unroll") for (int n = 0; n < 2; ++n) _Pragma("unroll") for (int k = 0; k < 2; ++k) dst[n][k] = *(const PG8_LAS bf16x8*)(lds + PG8_SB(b, h) + boff + n * 2048 + k * 1024); } while (0)
#define PG8_MMA(ai, bj, At, Bt) do { __builtin_amdgcn_s_setprio(1); _Pragma("unroll") for (int m = 0; m < 4; ++m) _Pragma("unroll") for (int n = 0; n < 2; ++n) _Pragma("unroll") for (int k = 0; k < 2; ++k) { \
        if constexpr (I8) acc[ai][bj][m][n] = __builtin_amdgcn_mfma_i32_16x16x64_i8(__builtin_bit_cast(i32x4, Bt[n][k]), __builtin_bit_cast(i32x4, At[m][k]), acc[ai][bj][m][n], 0, 0, 0); \
        else acc[ai][bj][m][n] = __builtin_amdgcn_mfma_f32_16x16x32_bf16(Bt[n][k], At[m][k], acc[ai][bj][m][n], 0, 0, 0); } __builtin_amdgcn_s_setprio(0); } while (0)
#define PG8_WAIT_V(n) asm volatile("s_waitcnt vmcnt(" #n ")" ::: "memory")
#define PG8_WAIT_L(n) asm volatile("s_waitcnt lgkmcnt(" #n ")" ::: "memory")
#define PG8_BAR __builtin_amdgcn_s_barrier()
#define PG8_SCHED __builtin_amdgcn_sched_barrier(0)
    Unit cur, nxt; int ui = 0;
    if (!S.next(0, cur)) return;
    typedef typename AccT<I8>::type acc_t;
    acc_t acc[2][2][4][2];
#pragma unroll
    for (int a = 0; a < 2; ++a)
#pragma unroll
        for (int b = 0; b < 2; ++b)
#pragma unroll
            for (int m = 0; m < 4; ++m)
#pragma unroll
                for (int n = 0; n < 2; ++n) acc[a][b][m][n] = (acc_t){0, 0, 0, 0};
    bf16x8 At[4][2], B0[2][2], B1[2][2];
    const char* cA = (const char*)g.A + (size_t)cur.pm * tstep; const char* cB = (const char*)g.Bt + (size_t)cur.pn * tstep;
    S.a_ready(cur);
    if constexpr (SP2) {
        PG8_STAGE(PG8_SB(0, 0), cB, voffB); PG8_STAGE(PG8_SB(0, 1), cB + hstep, voffB); PG8_STAGE(PG8_SA(0, 0), cA, voffA); PG8_STAGE(PG8_SA(0, 1), cA + hstep, voffA);
        if (wr == 1) PG8_BAR;
        PG8_WAIT_V(2); PG8_BAR;
        PG8_STAGE(PG8_SB(1, 0), cB + kstep, voffB); PG8_STAGE(PG8_SA(1, 0), cA + kstep, voffA); PG8_STAGE(PG8_SB(1, 1), cB + hstep + kstep, voffB);
        PG8_WAIT_V(6); PG8_BAR;
    } else {
        PG8_STAGE(PG8_SB(0, 0), cB, voffB); PG8_STAGE(PG8_SA(0, 0), cA, voffA); PG8_STAGE(PG8_SB(0, 1), cB + hstep, voffB); PG8_STAGE(PG8_SA(0, 1), cA + hstep, voffA);
        if (wr == 1) PG8_BAR;
        PG8_WAIT_V(4); PG8_BAR;
        PG8_STAGE(PG8_SB(1, 0), cB + kstep, voffB); PG8_STAGE(PG8_SA(1, 0), cA + kstep, voffA); PG8_STAGE(PG8_SB(1, 1), cB + hstep + kstep, voffB);
        PG8_WAIT_V(6); PG8_BAR;
    }
    for (;;) {
        const bool has_next = S.next(ui + 1, nxt);
        const char* nA = has_next ? (const char*)g.A + (size_t)nxt.pm * tstep : cA; const char* nB = has_next ? (const char*)g.Bt + (size_t)nxt.pn * tstep : cB;
        for (int t = 0; t < nt; t += 2) {
            const bool last = (t == nt - 2);
            const char* a1 = cA + (size_t)(t + 1) * kstep;
            const char* a2 = last ? nA : cA + (size_t)(t + 2) * kstep; const char* b2 = last ? nB : cB + (size_t)(t + 2) * kstep;
            const char* a3 = a2 + kstep; const char* b3 = b2 + kstep;
            if (last && has_next) S.a_ready(nxt);
            if constexpr (SP2) {
            PG8_LDB(B0, 0, 0); PG8_LDB(B1, 0, 1); PG8_SCHED; PG8_LDA(At, 0, 0); PG8_STAGE(PG8_SA(1, 1), a1 + hstep, voffA);
            PG8_WAIT_V(8); PG8_WAIT_L(0); PG8_BAR; PG8_MMA(0, 0, At, B0); PG8_MMA(0, 1, At, B1); PG8_BAR; PG8_SCHED;
            PG8_LDA(At, 0, 1); PG8_STAGE(PG8_SB(0, 0), b2, voffB); PG8_STAGE(PG8_SB(0, 1), b2 + hstep, voffB); PG8_STAGE(PG8_SA(0, 0), a2, voffA);
            PG8_WAIT_V(8); PG8_WAIT_L(0); PG8_BAR; PG8_MMA(1, 0, At, B0); PG8_MMA(1, 1, At, B1); PG8_BAR; PG8_SCHED;
            PG8_LDB(B0, 1, 0); PG8_LDB(B1, 1, 1); PG8_SCHED; PG8_LDA(At, 1, 0); PG8_STAGE(PG8_SA(0, 1), a2 + hstep, voffA);
            PG8_WAIT_V(8); PG8_WAIT_L(0); PG8_BAR; PG8_MMA(0, 0, At, B0); PG8_MMA(0, 1, At, B1); PG8_BAR; PG8_SCHED;
            PG8_LDA(At, 1, 1); PG8_STAGE(PG8_SB(1, 0), b3, voffB); PG8_STAGE(PG8_SB(1, 1), b3 + hstep, voffB); PG8_STAGE(PG8_SA(1, 0), a3, voffA);
            PG8_WAIT_V(8); PG8_WAIT_L(0); PG8_BAR; PG8_MMA(1, 0, At, B0); PG8_MMA(1, 1, At, B1); PG8_BAR; PG8_SCHED;
            } else {
            PG8_LDB(B0, 0, 0); PG8_SCHED; PG8_LDA(At, 0, 0); PG8_STAGE(PG8_SA(1, 1), a1 + hstep, voffA);
            PG8_WAIT_L(8); PG8_BAR; PG8_WAIT_L(0); PG8_MMA(0, 0, At, B0); PG8_BAR; PG8_SCHED;
            PG8_LDB(B1, 0, 1); PG8_STAGE(PG8_SB(0, 0), b2, voffB);
            PG8_BAR; PG8_WAIT_L(0); PG8_MMA(0, 1, At, B1); PG8_BAR;
            PG8_LDA(At, 0, 1); PG8_STAGE(PG8_SA(0, 0), a2, voffA);
            PG8_BAR; PG8_WAIT_L(0); PG8_MMA(1, 0, At, B0); PG8_BAR; PG8_SCHED;
            PG8_STAGE(PG8_SB(0, 1), b2 + hstep, voffB);
            PG8_WAIT_V(6); PG8_BAR; PG8_MMA(1, 1, At, B1); PG8_BAR;
            PG8_LDB(B0, 1, 0); PG8_SCHED; PG8_LDA(At, 1, 0); PG8_STAGE(PG8_SA(0, 1), a2 + hstep, voffA);
            PG8_WAIT_L(8); PG8_BAR; PG8_WAIT_L(0); PG8_MMA(0, 0, At, B0); PG8_BAR; PG8_SCHED;
            PG8_LDB(B1, 1, 1); PG8_STAGE(PG8_SB(1, 0), b3, voffB);
            PG8_BAR; PG8_WAIT_L(0); PG8_MMA(0, 1, At, B1); PG8_BAR;
            PG8_LDA(At, 1, 1); PG8_STAGE(PG8_SA(1, 0), a3, voffA);
            PG8_BAR; PG8_WAIT_L(0); PG8_MMA(1, 0, At, B0); PG8_BAR; PG8_SCHED;
            PG8_STAGE(PG8_SB(1, 1), b3 + hstep, voffB);
            PG8_WAIT_V(6); PG8_BAR; PG8_MMA(1, 1, At, B1); PG8_BAR;
            }
        }
        if constexpr (ALIGN_EPI) { if (wr == 0) PG8_BAR; }
        if constexpr (!Epi::AFTER_DRAIN) { E(acc, cur, wr, wc, fr, fq); S.done(cur); }
        if (!has_next) break;
#pragma unroll
        for (int a = 0; a < 2; ++a)
#pragma unroll
            for (int b = 0; b < 2; ++b)
#pragma unroll
                for (int m = 0; m < 4; ++m)
#pragma unroll
                    for (int n = 0; n < 2; ++n) acc[a][b][m][n] = (acc_t){0, 0, 0, 0};
        cur = nxt; cA = nA; cB = nB; ++ui;
        if constexpr (ALIGN_EPI) { if (wr == 1) PG8_BAR; }
    }
    PG8_WAIT_V(0);
    if constexpr (!ALIGN_EPI) { if (wr == 0) PG8_BAR; }
    PG8_BAR;
#undef PG8_SA
#undef PG8_SB
#undef PG8_STAGE
#undef PG8_LDA
#undef PG8_LDB
#undef PG8_MMA
#undef PG8_WAIT_V
#undef PG8_WAIT_L
#undef PG8_BAR
#undef PG8_SCHED
}
}

constexpr int NWAVES = 8;
constexpr int D = 4096, M = 16384, NIN = 14336, DFF = 11008, NGU = 2 * DFF, PLE = 256, HD = 128, NH = 16;
constexpr int COL_RQ = 0, COL_RK = 2048, COL_RV = 4096, COL_RG = 6144, COL_AQ = 8192, COL_AK = 10240, COL_AV = 12288;
constexpr float RMS_EPS = 1e-6f, GN_EPS = 1e-5f;

constexpr size_t MiB = 1u << 20;
constexpr size_t WS_CTL = 0, CTL_ZERO_BYTES = 2 * MiB;
constexpr size_t WS_WIN = 2 * MiB;
constexpr size_t WS_WOUT = WS_WIN + (size_t)NIN * D * 2;
constexpr size_t WS_WGU = WS_WOUT + (size_t)D * D * 2;
constexpr size_t WS_WDN = WS_WGU + (size_t)NGU * D * 2;
constexpr size_t WS_WPG = WS_WDN + (size_t)D * DFF * 2;
constexpr size_t WS_WPP = WS_WPG + (size_t)D * D * 2;
constexpr size_t WS_PBF = WS_WPP + (size_t)D * PLE * 2;
constexpr size_t WS_U = WS_PBF + (size_t)M * PLE * 2;
constexpr size_t WS_MIX = WS_U + (size_t)M * D * 2;
constexpr size_t WS_PP = WS_MIX + (size_t)M * D * 2;
constexpr size_t WS_Z = WS_PP + (size_t)M * D * 2;
constexpr size_t WS_YF = WS_Z + (size_t)M * NIN * 2;
constexpr size_t WS_OP = WS_YF + (size_t)M * 2048 * 4;
constexpr size_t WS_LP = WS_OP + (size_t)3 * M * 2048 * 2;
constexpr size_t WS_XB2 = WS_LP + (size_t)3 * NH * M * 4;
constexpr size_t WS_EXP = WS_XB2 + (size_t)M * D * 2;
constexpr size_t WS_RA = WS_EXP + (size_t)64 * 65536;
constexpr size_t WS_DB = WS_RA + (size_t)M * 4;
constexpr size_t WS_DBP = WS_DB + (size_t)NGU * 4;
constexpr size_t WS_DBI = WS_DBP + (size_t)D * 4;
constexpr size_t WS_WINQ = WS_DBI + (size_t)D * 4;
constexpr size_t WS_END = WS_WINQ + (size_t)D * D;
constexpr size_t WS_XQ = WS_OP + (size_t)2 * M * 2048 * 2;
constexpr size_t WS_CMAX = 256 * 1024, WS_RMAX = 512 * 1024;
constexpr size_t WS_CMAXI = 512 * 1024;
constexpr size_t WS_RMAXG = 640 * 1024, WS_CMAXP = 768 * 1024;
static_assert(WS_CMAX + 2 * (size_t)NGU * 4 <= WS_RMAX && WS_RMAX + 2 * (size_t)M * 4 <= WS_RMAXG && WS_RMAXG + 2 * (size_t)M * 4 <= WS_CMAXP && WS_CMAXP + 2 * (size_t)D * 4 <= 1024 * 1024, "control region map");

constexpr int CW_BAR = 4096, CW_QUEUE = 2048, CW_FLAG = 8192;
constexpr size_t WS_SS = 1 * MiB;
static_assert(WS_SS + 7 * (size_t)M * 8 <= CTL_ZERO_BYTES, "SS inside the memset region");
constexpr int LDSCTL_OFF = 144384, MISC_OFF = LDSCTL_OFF + 320;
constexpr int LDS_BYTES = 147456;

#define GAS __attribute__((address_space(1)))
#define LAS __attribute__((address_space(3)))
typedef unsigned short bf16;
typedef unsigned v4u __attribute__((ext_vector_type(4)));
typedef unsigned v2u __attribute__((ext_vector_type(2)));
typedef float f32x4 __attribute__((ext_vector_type(4)));
typedef short bf16x8 __attribute__((ext_vector_type(8)));
#define LDS_WAIT() asm volatile("s_waitcnt lgkmcnt(0)" ::: "memory")
#define WG_BARRIER() do { asm volatile("s_waitcnt lgkmcnt(0)" ::: "memory"); __builtin_amdgcn_s_barrier(); asm volatile("" ::: "memory"); } while (0)
__device__ __forceinline__ unsigned pk2(float lo, float hi) { return pg8::cvt_pk_bf16(lo, hi); }
__device__ __forceinline__ float bf_lo(unsigned w) { return __uint_as_float(w << 16); }
__device__ __forceinline__ float bf_hi(unsigned w) { return __uint_as_float(w & 0xffff0000u); }
#define MFMA16(a, b, c) __builtin_amdgcn_mfma_f32_16x16x32_bf16((a), (b), (c), 0, 0, 0)

#define XB_TMO      128
#define XB_XCNT(j)  (256  + 64 * (j))
#define XB_XSUB(j)  (1280 + 64 * (j))
#define XB_XGEN(j)  (2304 + 64 * (j))
#define XB_TOP      3328
#define XB_TOPGEN   3392
#define XCD_BAR_WORDS 3456
#define XB_SPIN_CAP (1u << 18)

__device__ __forceinline__ unsigned xb_ld(unsigned* p)              { return __hip_atomic_load(p, __ATOMIC_RELAXED, __HIP_MEMORY_SCOPE_AGENT); }
__device__ __forceinline__ unsigned xb_add(unsigned* p, unsigned v) { return __hip_atomic_fetch_add(p, v, __ATOMIC_RELAXED, __HIP_MEMORY_SCOPE_AGENT); }
__device__ __forceinline__ unsigned xb_xcc_id() { return (unsigned)__builtin_amdgcn_s_getreg((3 << 11) | 20) & 0xFu; }
#define XB_SPIN(cond, bar) do { unsigned _sp = 0; while (cond) { __builtin_amdgcn_s_sleep(1); \
    if ((++_sp & 255u) == 0u) { if (xb_ld(&(bar)[XB_TMO])) break; if (_sp > XB_SPIN_CAP) { atomicAdd(&(bar)[XB_TMO], 1u); break; } } } } while (0)

struct XcdBarrier { unsigned* bar; unsigned x; volatile LAS unsigned* st; };

__device__ __forceinline__ XcdBarrier xcd_barrier_post(unsigned* bar, volatile LAS unsigned* st) {
    XcdBarrier b; b.bar = bar; b.x = xb_xcc_id(); b.st = st;
    if (threadIdx.x == 0) (void)xb_add(&bar[XB_XCNT(b.x)], 1u);
    return b;
}
__device__ __forceinline__ void xcd_barrier_complete(unsigned* bar, unsigned x, unsigned& nloc, unsigned& nx) {
    const unsigned G = gridDim.x * gridDim.y * gridDim.z;
    unsigned sum, cnt, mine, sp = 0u;
    for (;;) {
        sum = 0u; cnt = 0u; mine = 0u;
#pragma unroll
        for (unsigned j = 0; j < 16; ++j) { const unsigned c = xb_ld(&bar[XB_XCNT(j)]); sum += c; cnt += (c > 0u) ? 1u : 0u; mine = (j == x) ? c : mine; }
        if (sum == G) break;
        __builtin_amdgcn_s_sleep(1);
        if ((++sp & 255u) == 0u) { if (xb_ld(&bar[XB_TMO])) break; if (sp > XB_SPIN_CAP) { atomicAdd(&bar[XB_TMO], 1u); break; } }
    }
    nloc = mine > 0u ? mine : 1u; nx = cnt > 0u ? cnt : 1u;
}
__device__ __forceinline__ void xcd_barrier(const XcdBarrier& b) {
    asm volatile("s_waitcnt vmcnt(0)" ::: "memory");
    __syncthreads();
    if (threadIdx.x == 0) {
        unsigned* bar = b.bar;
        __builtin_amdgcn_s_waitcnt(0);
        unsigned nloc = b.st[0], nx = b.st[1];
        if (nloc == 0u) { xcd_barrier_complete(bar, b.x, nloc, nx); b.st[0] = nloc; b.st[1] = nx; }
        const unsigned old = xb_add(&bar[XB_XSUB(b.x)], 1u);
        const unsigned gen = old / nloc;
        if (old + 1u == (gen + 1u) * nloc) {
            __builtin_amdgcn_fence(__ATOMIC_RELEASE, "agent");
            asm volatile("s_waitcnt vmcnt(0)" ::: "memory");
            const unsigned og = xb_add(&bar[XB_TOP], 1u);
            const unsigned tg = og / nx;
            if (og + 1u == (tg + 1u) * nx) xb_add(&bar[XB_TOPGEN], 1u);
            else XB_SPIN(xb_ld(&bar[XB_TOPGEN]) == tg, bar);
            __builtin_amdgcn_fence(__ATOMIC_ACQUIRE, "agent");
            xb_add(&bar[XB_XGEN(b.x)], 1u);
            asm volatile("s_waitcnt vmcnt(0)" ::: "memory");
        } else {
            XB_SPIN(xb_ld(&bar[XB_XGEN(b.x)]) == gen, bar);
            __builtin_amdgcn_fence(__ATOMIC_ACQUIRE, "agent");
            asm volatile("s_waitcnt vmcnt(0)" ::: "memory");
        }
    }
    __syncthreads();
}

#define DPP_ROR(v, ctrl) __builtin_bit_cast(float, __builtin_amdgcn_update_dpp(0, __builtin_bit_cast(int, (v)), (ctrl), 0xf, 0xf, false))
__device__ __forceinline__ float row16_sum_f(float v) { v += DPP_ROR(v, 0x128); v += DPP_ROR(v, 0x124); v += DPP_ROR(v, 0x122); v += DPP_ROR(v, 0x121); return v; }
__device__ __forceinline__ float row16_max_f(float v) { v = fmaxf(v, DPP_ROR(v, 0x128)); v = fmaxf(v, DPP_ROR(v, 0x124)); v = fmaxf(v, DPP_ROR(v, 0x122)); v = fmaxf(v, DPP_ROR(v, 0x121)); return v; }
__device__ __forceinline__ float wave_sum(float v) {
#pragma unroll
    for (int o = 1; o < 64; o <<= 1) v += __shfl_xor(v, o);
    return v;
}
constexpr int TR_SCR = 64 * 65 * 4 + 256;
__device__ __forceinline__ void transpose_item(const float* W, int K, int N, bf16* WT, size_t trow0, int k0, int n0, float sc, const float* gk, LAS float* scr, int lane) {
    f32x4 v[16];
    { const float* src = W + (size_t)(k0 + (lane >> 4)) * N + n0 + 4 * (lane & 15);
#pragma unroll
      for (int i = 0; i < 16; ++i) v[i] = __builtin_nontemporal_load((const GAS f32x4*)(src + (size_t)(4 * i) * N)); }
    const int c = lane & 7;
    f32x4 ga = (f32x4){1.f, 1.f, 1.f, 1.f}, gb = ga;
    if (gk) { ga = *(const GAS f32x4*)(gk + k0 + 8 * c); gb = *(const GAS f32x4*)(gk + k0 + 8 * c + 4); }
    { LAS float* d = scr + (lane >> 4) * 65 + 4 * (lane & 15);
#pragma unroll
      for (int i = 0; i < 16; ++i) { d[(4 * i) * 65 + 0] = v[i].x; d[(4 * i) * 65 + 1] = v[i].y; d[(4 * i) * 65 + 2] = v[i].z; d[(4 * i) * 65 + 3] = v[i].w; } }
    LDS_WAIT(); asm volatile("" ::: "memory");
    float g8[8];
#pragma unroll
    for (int q = 0; q < 8; ++q) g8[q] = gk ? (q < 4 ? ga[q] : gb[q - 4]) * sc : sc;
#pragma unroll
    for (int j = 0; j < 8; ++j) { const int n = (lane >> 3) + 8 * j; const LAS float* s = scr + (8 * c) * 65 + n;
        v4u o; o.x = pk2(s[0 * 65] * g8[0], s[1 * 65] * g8[1]); o.y = pk2(s[2 * 65] * g8[2], s[3 * 65] * g8[3]); o.z = pk2(s[4 * 65] * g8[4], s[5 * 65] * g8[5]); o.w = pk2(s[6 * 65] * g8[6], s[7 * 65] * g8[7]);
        *(GAS v4u*)(WT + (trow0 + n) * (size_t)K + k0 + 8 * c) = o; }
    LDS_WAIT(); asm volatile("" ::: "memory");
}
__device__ __forceinline__ void colmax_item(const float* W, int N, const float* gk, int k0, int n0, unsigned* cmax, int lane) {
    const float* src = W + (size_t)(k0 + (lane >> 4)) * N + n0 + 4 * (lane & 15);
    f32x4 mx = (f32x4){0.f, 0.f, 0.f, 0.f};
#pragma unroll
    for (int i = 0; i < 16; ++i) { const f32x4 v = __builtin_nontemporal_load((const GAS f32x4*)(src + (size_t)(4 * i) * N)); const float g = gk[k0 + (lane >> 4) + 4 * i];
        mx.x = fmaxf(mx.x, fabsf(v.x * g)); mx.y = fmaxf(mx.y, fabsf(v.y * g)); mx.z = fmaxf(mx.z, fabsf(v.z * g)); mx.w = fmaxf(mx.w, fabsf(v.w * g)); }
#pragma unroll
    for (int o = 16; o < 64; o <<= 1) { mx.x = fmaxf(mx.x, __shfl_xor(mx.x, o)); mx.y = fmaxf(mx.y, __shfl_xor(mx.y, o)); mx.z = fmaxf(mx.z, __shfl_xor(mx.z, o)); mx.w = fmaxf(mx.w, __shfl_xor(mx.w, o)); }
    if (lane < 16) { unsigned* c = cmax + n0 + 4 * lane; atomicMax(c, __float_as_uint(mx.x)); atomicMax(c + 1, __float_as_uint(mx.y)); atomicMax(c + 2, __float_as_uint(mx.z)); atomicMax(c + 3, __float_as_uint(mx.w)); }
}
__device__ __forceinline__ void colmax_wide(const float* W, int N, const float* gk, int k0, int n0, unsigned* cmax, int lane) {
    const float* src = W + (size_t)k0 * N + n0 + 4 * lane;
    f32x4 mx = (f32x4){0.f, 0.f, 0.f, 0.f};
#pragma unroll
    for (int b = 0; b < 4; ++b) { f32x4 v[16];
#pragma unroll
        for (int i = 0; i < 16; ++i) v[i] = __builtin_nontemporal_load((const GAS f32x4*)(src + (size_t)(16 * b + i) * N));
#pragma unroll
        for (int i = 0; i < 16; ++i) { const float g = gk[k0 + 16 * b + i];
            mx.x = fmaxf(mx.x, fabsf(v[i].x * g)); mx.y = fmaxf(mx.y, fabsf(v[i].y * g)); mx.z = fmaxf(mx.z, fabsf(v[i].z * g)); mx.w = fmaxf(mx.w, fabsf(v[i].w * g)); } }
    unsigned* c = cmax + n0 + 4 * lane; atomicMax(c, __float_as_uint(mx.x)); atomicMax(c + 1, __float_as_uint(mx.y)); atomicMax(c + 2, __float_as_uint(mx.z)); atomicMax(c + 3, __float_as_uint(mx.w));
}
__device__ __forceinline__ void transpose_item_q(const float* W, int K, int N, signed char* WQ, size_t trow0, int k0, int n0, const float* gk, const unsigned* cmax, float* DB, LAS float* scr, int lane) {
    f32x4 v[16];
    const int c = lane & 7;
    { const float* src = W + (size_t)(k0 + (lane >> 4)) * N + n0 + 4 * (lane & 15);
#pragma unroll
      for (int i = 0; i < 16; ++i) v[i] = __builtin_nontemporal_load((const GAS f32x4*)(src + (size_t)(4 * i) * N)); }
    const f32x4 ga = *(const GAS f32x4*)(gk + k0 + 8 * c), gb = *(const GAS f32x4*)(gk + k0 + 8 * c + 4);
    float cmv[8];
#pragma unroll
    for (int j = 0; j < 8; ++j) cmv[j] = __uint_as_float(*(const GAS unsigned*)(cmax + n0 + (lane >> 3) + 8 * j));
    { LAS float* d = scr + (lane >> 4) * 65 + 4 * (lane & 15);
#pragma unroll
      for (int i = 0; i < 16; ++i) { d[(4 * i) * 65 + 0] = v[i].x; d[(4 * i) * 65 + 1] = v[i].y; d[(4 * i) * 65 + 2] = v[i].z; d[(4 * i) * 65 + 3] = v[i].w; } }
    LDS_WAIT(); asm volatile("" ::: "memory");
    const float g8[8] = {ga.x, ga.y, ga.z, ga.w, gb.x, gb.y, gb.z, gb.w};
#pragma unroll
    for (int j = 0; j < 8; ++j) { const int n = (lane >> 3) + 8 * j; const LAS float* s = scr + (8 * c) * 65 + n;
        const float cm = cmv[j]; const float inv = cm > 0.f ? 127.0f * __builtin_amdgcn_rcpf(cm) : 0.f;
        int q8[8];
#pragma unroll
        for (int q = 0; q < 8; ++q) q8[q] = (int)rintf(s[q * 65] * g8[q] * inv);
        v2u o; o.x = (unsigned)(q8[0] & 255) | ((unsigned)(q8[1] & 255) << 8) | ((unsigned)(q8[2] & 255) << 16) | ((unsigned)(q8[3] & 255) << 24);
        o.y = (unsigned)(q8[4] & 255) | ((unsigned)(q8[5] & 255) << 8) | ((unsigned)(q8[6] & 255) << 16) | ((unsigned)(q8[7] & 255) << 24);
        *(GAS v2u*)(WQ + (trow0 + n) * (size_t)K + k0 + 8 * c) = o;
        if (k0 == 0 && c == 0) DB[trow0 + n] = cm * (1.0f / 127.0f); }
    LDS_WAIT(); asm volatile("" ::: "memory");
}
struct QRow { v4u x[8]; };
__device__ __forceinline__ void quant_load(QRow& r, const bf16* xrow, int lane) {
    const GAS v4u* xr = (const GAS v4u*)xrow + lane;
#pragma unroll
    for (int j = 0; j < 8; ++j) r.x[j] = xr[64 * j];
}
__device__ __forceinline__ void quant_finish(const QRow& r, signed char* qrow, float* ra, int lane) {
    GAS v2u* qr = (GAS v2u*)qrow + lane;
    float rm = 0.f, ss = 0.f;
#pragma unroll
    for (int j = 0; j < 8; ++j)
#pragma unroll
        for (int q = 0; q < 4; ++q) { const float a = bf_lo(r.x[j][q]), b = bf_hi(r.x[j][q]); rm = fmaxf(rm, fmaxf(fabsf(a), fabsf(b))); ss += a * a + b * b; }
    rm = row16_max_f(rm); ss = row16_sum_f(ss);
    { const float r1 = __shfl_xor(rm, 16), s1 = __shfl_xor(ss, 16); rm = fmaxf(rm, r1); ss += s1; }
    { const float r1 = __shfl_xor(rm, 32), s1 = __shfl_xor(ss, 32); rm = fmaxf(rm, r1); ss += s1; }
    const float inv = rm > 0.f ? 127.0f * __builtin_amdgcn_rcpf(rm) : 0.f;
#pragma unroll
    for (int j = 0; j < 8; ++j) { int q8[8];
#pragma unroll
        for (int q = 0; q < 4; ++q) { q8[2 * q] = (int)rintf(bf_lo(r.x[j][q]) * inv); q8[2 * q + 1] = (int)rintf(bf_hi(r.x[j][q]) * inv); }
        v2u o; o.x = (unsigned)(q8[0] & 255) | ((unsigned)(q8[1] & 255) << 8) | ((unsigned)(q8[2] & 255) << 16) | ((unsigned)(q8[3] & 255) << 24);
        o.y = (unsigned)(q8[4] & 255) | ((unsigned)(q8[5] & 255) << 8) | ((unsigned)(q8[6] & 255) << 16) | ((unsigned)(q8[7] & 255) << 24);
        qr[64 * j] = o; }
    if (lane == 0) *ra = __builtin_amdgcn_rsqf(ss * (1.0f / 4096.0f) + 1e-6f) * rm * (1.0f / 127.0f);
}
__device__ __forceinline__ void quant_pass(const bf16* X, signed char* XQ, float* RA, int first, int step, int lane) {
    QRow A, B; int m = first;
    if (m < M) quant_load(A, X + (size_t)m * D, lane);
    _Pragma("nounroll") for (; m < M; m += 2 * step) {
        const int m1 = m + step, m2 = m + 2 * step;
        if (m1 < M) quant_load(B, X + (size_t)m1 * D, lane);
        quant_finish(A, XQ + (size_t)m * D, RA + m, lane);
        if (m2 < M) quant_load(A, X + (size_t)m2 * D, lane);
        if (m1 < M) quant_finish(B, XQ + (size_t)m1 * D, RA + m1, lane);
    }
}
constexpr int CV_IN = (D / 64) * (NIN / 64), CV_PP = (PLE / 64) * (D / 64), CV_A = CV_IN + CV_PP;
constexpr int CV_OUT = (D / 64) * (D / 64), CV_G = (D / 64) * (DFF / 64), CV_DN = (DFF / 64) * (D / 64), CV_ALL = CV_A + CV_OUT + 2 * CV_G + CV_DN + CV_OUT;
struct CvPtrs { const float *w_in, *w_pp, *w_out, *w_gate, *w_up, *w_down, *w_pg, *g_mix, *g_ffn, *g_ple; bf16 *WinT, *WppT, *WoutT, *WguT, *WdnT, *WpgT; const unsigned* cmax; float* DB; const unsigned* cmaxp; float* DBP; signed char* WinQ; const unsigned* cmaxi; float* DBI; };
__device__ __forceinline__ void convert_item(const CvPtrs& P, int it, LAS float* scr, int lane) {
    int r = it;
    if (r < CV_IN) { const int nblk = NIN / 64, kb = r / nblk, n0 = 64 * (r % nblk); const float sc = (n0 >= COL_RK && n0 < COL_RV) ? 0.08838834764831845f : 1.0f;
        const bool isv = (n0 >= COL_RV && n0 < COL_RG) || n0 >= COL_AV;
        if (isv) transpose_item_q(P.w_in, D, NIN, P.WinQ, (size_t)(n0 < COL_RG ? n0 - COL_RV : n0 - COL_AV + 2048), 64 * kb, n0, P.g_mix, P.cmaxi, P.DBI, scr, lane);
        else transpose_item(P.w_in, D, NIN, P.WinT, (size_t)(n0 < COL_RV ? n0 : n0 - 2048), 64 * kb, n0, sc, P.g_mix, scr, lane);
        return; } r -= CV_IN;
    if (r < CV_PP) { const int nblk = D / 64, kb = r / nblk, n0 = 64 * (r % nblk); transpose_item(P.w_pp, PLE, D, P.WppT, (size_t)n0, 64 * kb, n0, 1.0f, nullptr, scr, lane); return; } r -= CV_PP;
    if (r < CV_OUT) { const int nblk = D / 64, kb = r / nblk, n0 = 64 * (r % nblk); transpose_item(P.w_out, D, D, P.WoutT, (size_t)n0, 64 * kb, n0, 1.0f, nullptr, scr, lane); return; } r -= CV_OUT;
    if (r < CV_G) { const int nblk = DFF / 64, kb = r / nblk, n0 = 64 * (r % nblk); transpose_item_q(P.w_gate, D, DFF, (signed char*)P.WguT, (size_t)((n0 >> 7) * 256 + (n0 & 127)), 64 * kb, n0, P.g_ffn, P.cmax, P.DB, scr, lane); return; } r -= CV_G;
    if (r < CV_G) { const int nblk = DFF / 64, kb = r / nblk, n0 = 64 * (r % nblk); transpose_item_q(P.w_up, D, DFF, (signed char*)P.WguT, (size_t)((n0 >> 7) * 256 + 128 + (n0 & 127)), 64 * kb, n0, P.g_ffn, P.cmax + DFF, P.DB, scr, lane); return; } r -= CV_G;
    if (r < CV_DN) { const int nblk = D / 64, kb = r / nblk, n0 = 64 * (r % nblk); transpose_item(P.w_down, DFF, D, P.WdnT, (size_t)n0, 64 * kb, n0, 1.0f, nullptr, scr, lane); return; } r -= CV_DN;
    { const int nblk = D / 64, kb = r / nblk, n0 = 64 * (r % nblk); transpose_item_q(P.w_pg, D, D, (signed char*)P.WpgT, (size_t)n0, 64 * kb, n0, P.g_ple, P.cmaxp, P.DBP, scr, lane); }
}
#define CV_PTRS(P, ka, ws, layer) CvPtrs P; P.w_in = ka->in[5] + (size_t)(layer) * D * NIN; P.w_pp = ka->in[17] + (size_t)(layer) * PLE * D; P.w_out = ka->in[10] + (size_t)(layer) * D * D; \
    P.w_gate = ka->in[12] + (size_t)(layer) * D * DFF; P.w_up = ka->in[13] + (size_t)(layer) * D * DFF; P.w_down = ka->in[14] + (size_t)(layer) * DFF * D; P.w_pg = ka->in[16] + (size_t)(layer) * D * D; \
    P.g_mix = ka->in[4] + (size_t)(layer) * D; P.g_ffn = ka->in[11] + (size_t)(layer) * D; P.g_ple = ka->in[15] + (size_t)(layer) * D; \
    P.WinT = (bf16*)(ws + WS_WIN); P.WppT = (bf16*)(ws + WS_WPP); P.WoutT = (bf16*)(ws + WS_WOUT); P.WguT = (bf16*)(ws + WS_WGU); P.WdnT = (bf16*)(ws + WS_WDN); P.WpgT = (bf16*)(ws + WS_WPG); \
    P.cmax = (const unsigned*)(ws + WS_CMAX) + (size_t)(layer) * NGU; P.DB = (float*)(ws + WS_DB); P.cmaxp = (const unsigned*)(ws + WS_CMAXP) + (size_t)(layer) * D; P.DBP = (float*)(ws + WS_DBP); \
    P.WinQ = (signed char*)(ws + WS_WINQ); P.cmaxi = (const unsigned*)(ws + WS_CMAXI) + (size_t)(layer) * NIN; P.DBI = (float*)(ws + WS_DBI)

__device__ __forceinline__ void x_row_in(const float* xrow, bf16* orow, pg8::u64_t* ss, signed char* qrow, float* ra, int lane) {
    const GAS f32x4* xr = (const GAS f32x4*)xrow + lane;
    f32x4 v[16];
#pragma unroll
    for (int j = 0; j < 16; ++j) v[j] = __builtin_nontemporal_load(xr + 64 * j);
    GAS v2u* o8 = (GAS v2u*)orow + lane; float s = 0.f, mx = 0.f;
#pragma unroll
    for (int j = 0; j < 16; ++j) { v2u o; o.x = pk2(v[j].x, v[j].y); o.y = pk2(v[j].z, v[j].w); o8[64 * j] = o;
        const float a = bf_lo(o.x), b = bf_hi(o.x), c = bf_lo(o.y), d = bf_hi(o.y); s += (a * a + b * b) + (c * c + d * d); v[j] = (f32x4){a, b, c, d};
        mx = fmaxf(mx, fmaxf(fmaxf(fabsf(a), fabsf(b)), fmaxf(fabsf(c), fabsf(d)))); }
    s = row16_sum_f(s); mx = row16_max_f(mx);
    { const float m1 = __shfl_xor(mx, 16), s1 = __shfl_xor(s, 16); mx = fmaxf(mx, m1); s += s1; }
    { const float m1 = __shfl_xor(mx, 32), s1 = __shfl_xor(s, 32); mx = fmaxf(mx, m1); s += s1; }
    const pg8::u64_t sf = pg8::ss_fix(s); const float inv = mx > 0.f ? 127.0f * __builtin_amdgcn_rcpf(mx) : 0.f;
    GAS unsigned* q4 = (GAS unsigned*)qrow + lane;
#pragma unroll
    for (int j = 0; j < 16; ++j) { const int q0 = (int)rintf(v[j].x * inv), q1 = (int)rintf(v[j].y * inv), q2 = (int)rintf(v[j].z * inv), q3 = (int)rintf(v[j].w * inv);
        q4[64 * j] = (unsigned)(q0 & 255) | ((unsigned)(q1 & 255) << 8) | ((unsigned)(q2 & 255) << 16) | ((unsigned)(q3 & 255) << 24); }
    if (lane == 0) { *ss = sf; *ra = pg8::ss_rs(sf) * mx * (1.0f / 127.0f); }
}

__device__ __forceinline__ float fast_rsqrt(float x) { return __builtin_amdgcn_rsqf(x); }
__device__ __forceinline__ float row16_sum(float v) {
    v += __builtin_bit_cast(float, __builtin_amdgcn_update_dpp(0, __builtin_bit_cast(int, v), 0x128, 0xf, 0xf, false));
    v += __builtin_bit_cast(float, __builtin_amdgcn_update_dpp(0, __builtin_bit_cast(int, v), 0x124, 0xf, 0xf, false));
    v += __builtin_bit_cast(float, __builtin_amdgcn_update_dpp(0, __builtin_bit_cast(int, v), 0x122, 0xf, 0xf, false));
    v += __builtin_bit_cast(float, __builtin_amdgcn_update_dpp(0, __builtin_bit_cast(int, v), 0x121, 0xf, 0xf, false));
    return v;
}
constexpr int RS = 272;
constexpr int RSB = 288;
constexpr int R_K = 0, R_KW = 128 * RS, R_V = R_KW + 128 * RSB, R_ST = R_V + 128 * RSB;
constexpr int R_GN = R_ST + 128 * RS;
static_assert(R_GN + 512 <= LDSCTL_OFF, "retention LDS");
typedef short s16x4 __attribute__((ext_vector_type(4)));
__device__ __forceinline__ s16x4 ds_tr(LAS unsigned char* p) { return __builtin_bit_cast(s16x4, __builtin_amdgcn_ds_read_tr16_b64_v4i16((LAS s16x4*)p)); }
__device__ __forceinline__ bf16x8 ds_tr2(LAS unsigned char* p, int rstride) { const s16x4 a = ds_tr(p), b = ds_tr(p + 16 * rstride); bf16x8 r; r[0] = a[0]; r[1] = a[1]; r[2] = a[2]; r[3] = a[3]; r[4] = b[0]; r[5] = b[1]; r[6] = b[2]; r[7] = b[3]; return r; }
__device__ __forceinline__ v4u scale8(v4u x, float sc) { v4u o; o.x = pk2(bf_lo(x.x) * sc, bf_hi(x.x) * sc); o.y = pk2(bf_lo(x.y) * sc, bf_hi(x.y) * sc); o.z = pk2(bf_lo(x.z) * sc, bf_hi(x.z) * sc); o.w = pk2(bf_lo(x.w) * sc, bf_hi(x.w) * sc); return o; }

__device__ __forceinline__ void seq_info(int seq, int& rowbase, int& L) { if (seq < 2) { rowbase = seq * 4096; L = 4096; } else { rowbase = 8192 + (seq - 2) * 2048; L = 2048; } }
__device__ __forceinline__ const bf16* zplane(const bf16* ZH, int sec, int h) { return ZH + (size_t)(sec * NH + h) * M * HD; }

#define RLX_AGENT __ATOMIC_RELAXED, __HIP_MEMORY_SCOPE_AGENT
template <int DIR, bool INTRA, bool FINAL> __device__ __forceinline__ void retention_pass(LAS unsigned char* lds, const bf16* ZH, bf16* YF, bf16* MIX, const float* ld, const float* gn, int seq, int h, int n0, int ncnt,
                                                                                          const unsigned long long* imp, unsigned* impflag, unsigned long long* expo, unsigned* expflag, int tid0) {
    int rowbase, L; seq_info(seq, rowbase, L);
    const bf16* Qp = zplane(ZH, 0, h) + (size_t)rowbase * HD; const bf16* Kp = zplane(ZH, 1, h) + (size_t)rowbase * HD;
    const bf16* Vp = zplane(ZH, 2, h) + (size_t)rowbase * HD; const bf16* Gp = zplane(ZH, 3, h) + (size_t)rowbase * HD;
    const float lf0 = ld[h], lb0 = ld[NH + h];
    f32x4 st[8];
    {
        const float gC = __expf((DIR == 0 ? lf0 : lb0) * 128.f);
        v4u kreg[4], vreg[4]; bf16x8 qf[4];
        { const int n = DIR == 0 ? n0 : n0 + ncnt - 1; const int srow = tid0 >> 4, sch = tid0 & 15, w = tid0 >> 6, lr = tid0 & 15, lg = (tid0 >> 4) & 3;
#pragma unroll
          for (int cc = 0; cc < 4; ++cc) { kreg[cc] = *(const GAS v4u*)(Kp + (size_t)(n * 128 + srow + 32 * cc) * HD + 8 * sch); vreg[cc] = *(const GAS v4u*)(Vp + (size_t)(n * 128 + srow + 32 * cc) * HD + 8 * sch); }
#pragma unroll
          for (int ks = 0; ks < 4; ++ks) qf[ks] = *(const GAS bf16x8*)(Qp + (size_t)(n * 128 + 16 * w + lr) * HD + 8 * lg + 32 * ks); }
        if (imp) {
            if (tid0 == 0) { unsigned spins = 0; while (__hip_atomic_load(impflag, RLX_AGENT) == 0u && ++spins < (1u << 22)) __builtin_amdgcn_s_sleep(2); }
            __syncthreads();
#pragma unroll
            for (int e = 0; e < 8; ++e) { const unsigned long long a = __hip_atomic_load(imp + (size_t)(e * 512 + tid0) * 2, RLX_AGENT), b = __hip_atomic_load(imp + (size_t)(e * 512 + tid0) * 2 + 1, RLX_AGENT);
                st[e][0] = __uint_as_float((unsigned)a); st[e][1] = __uint_as_float((unsigned)(a >> 32)); st[e][2] = __uint_as_float((unsigned)b); st[e][3] = __uint_as_float((unsigned)(b >> 32)); }
        } else {
#pragma unroll
            for (int e = 0; e < 8; ++e) st[e] = (f32x4){0.f, 0.f, 0.f, 0.f};
        }
        if constexpr (FINAL) {
            if (tid0 < 32) *(LAS f32x4*)(lds + R_GN + 16 * tid0) = *(const GAS f32x4*)(gn + h * HD + 4 * tid0);
        }
        for (int cn = 0; cn < ncnt; ++cn) {
            const int n = DIR == 0 ? n0 + cn : n0 + ncnt - 1 - cn, nn = DIR == 0 ? n + 1 : n - 1;
            const int r0 = rowbase + n * 128;
            int tid = tid0; float lf = lf0, lb = lb0; asm volatile("" : "+v"(tid), "+v"(lf), "+v"(lb));
            const int w = tid >> 6, l = tid & 63, lr = l & 15, lg = l >> 4, srow = tid >> 4, sch = tid & 15;
            LAS unsigned char* trp = lds + (4 * lg + ((l & 15) >> 2)) * RSB + (l & 3) * 8;
            WG_BARRIER();
#pragma unroll
            for (int cc = 0; cc < 4; ++cc) { const int row = srow + 32 * cc;
                if constexpr (INTRA) *(LAS v4u*)(lds + R_K + row * RS + 16 * sch) = kreg[cc];
                const float wj = DIR == 0 ? __expf(lf * (float)(127 - row)) : __expf(lb * (float)row);
                *(LAS v4u*)(lds + R_KW + row * RSB + 16 * sch) = scale8(kreg[cc], wj);
                *(LAS v4u*)(lds + R_V + row * RSB + 16 * sch) = vreg[cc]; }
#pragma unroll
            for (int e = 0; e < 8; ++e) { v2u o; o.x = pk2(st[e][0], st[e][1]); o.y = pk2(st[e][2], st[e][3]); *(LAS v2u*)(lds + R_ST + (16 * e + lr) * RS + (16 * w + 4 * lg) * 2) = o; }
            WG_BARRIER();
            bf16x8 qx[4];
            { const float xi = DIR == 0 ? __expf(lf * (float)(16 * w + lr + 1)) : __expf(lb * (float)(128 - 16 * w - lr));
#pragma unroll
              for (int ks = 0; ks < 4; ++ks) qx[ks] = __builtin_bit_cast(bf16x8, scale8(__builtin_bit_cast(v4u, qf[ks]), xi)); }
            bf16x8 pt[4];
            if constexpr (INTRA) {
                f32x4 s[8];
#pragma unroll
                for (int jt = 0; jt < 8; ++jt) { s[jt] = (f32x4){0.f, 0.f, 0.f, 0.f};
#pragma unroll
                    for (int ks = 0; ks < 4; ++ks) { const bf16x8 a = *(const LAS bf16x8*)(lds + R_K + (16 * jt + lr) * RS + (8 * lg + 32 * ks) * 2); s[jt] = MFMA16(a, qf[ks], s[jt]); }
                    __builtin_amdgcn_sched_barrier(0); }
                float Fr[4], Br[4];
#pragma unroll
                for (int r = 0; r < 4; ++r) { const float br = (float)(lr - 4 * lg - r); Fr[r] = __expf(lf * br); Br[r] = __expf(-lb * br); }
#pragma unroll
                for (int jt = 0; jt < 8; ++jt) { const int dt = w - jt; const float cf = __expf(lf * 16.f * (float)dt), cb = __expf(-lb * 16.f * (float)dt);
#pragma unroll
                    for (int r = 0; r < 4; ++r) { const float dec = dt > 0 ? Fr[r] * cf : (dt < 0 ? Br[r] * cb : ((lr - 4 * lg - r) >= 0 ? Fr[r] : Br[r])); s[jt][r] *= dec; } }
#pragma unroll
                for (int ks = 0; ks < 4; ++ks) { v4u o; o.x = pk2(s[2 * ks][0], s[2 * ks][1]); o.y = pk2(s[2 * ks][2], s[2 * ks][3]); o.z = pk2(s[2 * ks + 1][0], s[2 * ks + 1][1]); o.w = pk2(s[2 * ks + 1][2], s[2 * ks + 1][3]); pt[ks] = __builtin_bit_cast(bf16x8, o); }
            }
            f32x4 y[8];
#pragma unroll
            for (int e = 0; e < 8; ++e) y[e] = (f32x4){0.f, 0.f, 0.f, 0.f};
            { bf16x8 kwf[4];
#pragma unroll
              for (int ks = 0; ks < 4; ++ks) kwf[ks] = ds_tr2(trp + R_KW + (32 * ks) * RSB + (16 * w) * 2, RSB);
#pragma unroll
              for (int e = 0; e < 8; ++e) { st[e] = st[e] * gC;
#pragma unroll
                for (int ks = 0; ks < 4; ++ks) { const bf16x8 vf = ds_tr2(trp + R_V + (32 * ks) * RSB + (16 * e) * 2, RSB);
                    if constexpr (INTRA) y[e] = MFMA16(vf, pt[ks], y[e]);
                    st[e] = MFMA16(kwf[ks], vf, st[e]); }
                __builtin_amdgcn_sched_barrier(0); } }
            v2u ywv[8], gwv[8];
            if constexpr (FINAL) { const int row_ = r0 + 16 * w + lr; const bf16* yp_ = YF + (size_t)row_ * 2048 + h * HD + 4 * lg; const bf16* gp_ = Gp + (size_t)(n * 128 + 16 * w + lr) * HD + 4 * lg;
#pragma unroll
                for (int e = 0; e < 8; ++e) { ywv[e] = *(const GAS v2u*)(yp_ + 16 * e); gwv[e] = *(const GAS v2u*)(gp_ + 16 * e); } }
            if (cn + 1 < ncnt) {
#pragma unroll
              for (int cc = 0; cc < 4; ++cc) { kreg[cc] = *(const GAS v4u*)(Kp + (size_t)(nn * 128 + srow + 32 * cc) * HD + 8 * sch); vreg[cc] = *(const GAS v4u*)(Vp + (size_t)(nn * 128 + srow + 32 * cc) * HD + 8 * sch); }
#pragma unroll
              for (int ks = 0; ks < 4; ++ks) qf[ks] = *(const GAS bf16x8*)(Qp + (size_t)(nn * 128 + 16 * w + lr) * HD + 8 * lg + 32 * ks); }
#pragma unroll
            for (int e = 0; e < 8; ++e) {
#pragma unroll
                for (int ks = 0; ks < 4; ++ks) { const bf16x8 sf = *(const LAS bf16x8*)(lds + R_ST + (16 * e + lr) * RS + (8 * lg + 32 * ks) * 2); y[e] = MFMA16(sf, qx[ks], y[e]); }
                __builtin_amdgcn_sched_barrier(0); }
            const int row = r0 + 16 * w + lr;
            bf16* yp = YF + (size_t)row * 2048 + h * HD + 4 * lg;
            if constexpr (!FINAL) {
#pragma unroll
                for (int e = 0; e < 8; ++e) { v2u o; o.x = pk2(y[e][0], y[e][1]); o.y = pk2(y[e][2], y[e][3]); *(GAS v2u*)(yp + 16 * e) = o; }
            } else {
                float sum = 0.f;
#pragma unroll
                for (int e = 0; e < 8; ++e) { const v2u yw = ywv[e]; y[e][0] += bf_lo(yw.x); y[e][1] += bf_hi(yw.x); y[e][2] += bf_lo(yw.y); y[e][3] += bf_hi(yw.y); sum += (y[e][0] + y[e][1]) + (y[e][2] + y[e][3]); }
                sum += __shfl_xor(sum, 16); sum += __shfl_xor(sum, 32);
                const float mu = sum * (1.f / 128.f); float q = 0.f;
#pragma unroll
                for (int e = 0; e < 8; ++e) { y[e] = y[e] - mu; q += (y[e][0] * y[e][0] + y[e][1] * y[e][1]) + (y[e][2] * y[e][2] + y[e][3] * y[e][3]); }
                q += __shfl_xor(q, 16); q += __shfl_xor(q, 32);
                const float rstd = fast_rsqrt(q * (1.f / 128.f) + GN_EPS);
                bf16* mp = MIX + (size_t)row * D + h * HD + 4 * lg;
#pragma unroll
                for (int e = 0; e < 8; ++e) { const v2u gw2 = gwv[e]; const f32x4 gg = *(const LAS f32x4*)(lds + R_GN + (16 * e + 4 * lg) * 4);
                    const float g0 = bf_lo(gw2.x), g1 = bf_hi(gw2.x), g2 = bf_lo(gw2.y), g3 = bf_hi(gw2.y);
                    v2u o; o.x = pk2(g0 * pg8::fast_sigmoid(g0) * (y[e][0] * rstd * gg.x), g1 * pg8::fast_sigmoid(g1) * (y[e][1] * rstd * gg.y));
                    o.y = pk2(g2 * pg8::fast_sigmoid(g2) * (y[e][2] * rstd * gg.z), g3 * pg8::fast_sigmoid(g3) * (y[e][3] * rstd * gg.w));
                    *(GAS v2u*)(mp + 16 * e) = o; }
            }
        }
        if (expo) {
#pragma unroll
            for (int e = 0; e < 8; ++e) { __hip_atomic_store(expo + (size_t)(e * 512 + tid0) * 2, (unsigned long long)__float_as_uint(st[e][0]) | ((unsigned long long)__float_as_uint(st[e][1]) << 32), RLX_AGENT);
                __hip_atomic_store(expo + (size_t)(e * 512 + tid0) * 2 + 1, (unsigned long long)__float_as_uint(st[e][2]) | ((unsigned long long)__float_as_uint(st[e][3]) << 32), RLX_AGENT); }
            asm volatile("s_waitcnt vmcnt(0)" ::: "memory");
            __syncthreads();
            if (tid0 == 0) __hip_atomic_store(expflag, 1u, RLX_AGENT);
        }
        __syncthreads();
    }
}

__device__ __forceinline__ void retention_item(LAS unsigned char* lds, const bf16* ZH, bf16* YF, bf16* MIX, const float* ld, const float* gn, unsigned long long* EXP, unsigned* flags, int item, int tid0) {
    if (item < 64) {
        const int chain = item & 31, seq = chain >> 4, h = chain & 15;
        unsigned long long* slot_f = EXP + (size_t)(chain * 2 + 0) * 8192; unsigned long long* slot_b = EXP + (size_t)(chain * 2 + 1) * 8192;
        unsigned* flag_f = flags + 64 * (chain * 2 + 0); unsigned* flag_b = flags + 64 * (chain * 2 + 1);
        if (item < 32) { retention_pass<0, true, false>(lds, ZH, YF, MIX, ld, gn, seq, h, 0, 16, nullptr, nullptr, slot_f, flag_f, tid0);
                         retention_pass<1, false, true>(lds, ZH, YF, MIX, ld, gn, seq, h, 0, 16, slot_b, flag_b, nullptr, nullptr, tid0); }
        else           { retention_pass<1, false, false>(lds, ZH, YF, MIX, ld, gn, seq, h, 16, 16, nullptr, nullptr, slot_b, flag_b, tid0);
                         retention_pass<0, true, true>(lds, ZH, YF, MIX, ld, gn, seq, h, 16, 16, slot_f, flag_f, nullptr, nullptr, tid0); }
    } else {
        const int c = item - 64, seq = 2 + (c >> 4), h = c & 15;
        retention_pass<0, true, false>(lds, ZH, YF, MIX, ld, gn, seq, h, 0, 16, nullptr, nullptr, nullptr, nullptr, tid0);
        retention_pass<1, false, true>(lds, ZH, YF, MIX, ld, gn, seq, h, 0, 16, nullptr, nullptr, nullptr, nullptr, tid0);
    }
}

constexpr int A_K = 0, A_V = 256 * RS;
static_assert(A_V + 256 * RSB <= LDSCTL_OFF, "attention LDS");
struct AttBlk { int d, dsh, r, qi0, m, b; };
__device__ __forceinline__ AttBlk att_blk(int blk, int t0, int L) {
    AttBlk a;
    if (blk < 16) { a.dsh = 4; a.r = blk; a.b = 0; } else if (blk < 32) { a.dsh = 2; a.r = (blk - 16) >> 2; a.b = (blk - 16) & 3; } else { a.dsh = 0; a.r = 0; a.b = blk - 32; }
    a.d = 1 << a.dsh; a.m = L >> a.dsh; a.qi0 = (t0 >> a.dsh) + 128 * a.b; return a;
}
__device__ __forceinline__ void attention_item(LAS unsigned char* lds, const bf16* ZH, bf16* OP, float* LP, bf16* MIX, const float* qg, const float* kg, int item, int tid0) {
    const int s8 = item >> 4, h = item & 15;
    int seq, t0; if (s8 < 4) { seq = s8 >> 1; t0 = (s8 & 1) * 2048; } else { seq = s8 - 2; t0 = 0; }
    int rowbase, L; seq_info(seq, rowbase, L);
    const float slope = exp2f(-0.5f * (float)(h + 1));
    float smax;
    { const int l = tid0 & 63; float mq = fmaxf(fabsf(qg[l]), fabsf(qg[l + 64])), mk = fmaxf(fabsf(kg[l]), fabsf(kg[l + 64]));
#pragma unroll
      for (int o = 1; o < 64; o <<= 1) { mq = fmaxf(mq, __shfl_xor(mq, o)); mk = fmaxf(mk, __shfl_xor(mk, o)); }
      smax = mq * mk * 11.3137085f; }
    const bf16* Qp = zplane(ZH, 4, h) + (size_t)rowbase * HD; const bf16* Kp = zplane(ZH, 5, h) + (size_t)rowbase * HD; const bf16* Vp = zplane(ZH, 6, h) + (size_t)rowbase * HD;
    auto att_load = [&](v4u (&kq)[8], v4u (&vq)[8], int BLK) __attribute__((always_inline)) {
        const AttBlk nb_ = att_blk(BLK, t0, L); const int krow_ = tid0 >> 4, kc_ = tid0 & 15;
#pragma unroll
        for (int p = 0; p < 8; ++p) if (p >= 4 || nb_.b == 0) { const int kidx = nb_.qi0 - 64 + 32 * p + krow_; kq[p] = (v4u){0u, 0u, 0u, 0u}; vq[p] = (v4u){0u, 0u, 0u, 0u};
            if ((unsigned)kidx < (unsigned)nb_.m) { const unsigned ro = (unsigned)((nb_.r + nb_.d * kidx) * HD + 8 * kc_) * 2u; kq[p] = *(const GAS v4u*)((const GAS char*)Kp + ro); vq[p] = *(const GAS v4u*)((const GAS char*)Vp + ro); } }
    };
    auto att_load_q = [&](v4u (&qw)[4], int BLK) __attribute__((always_inline)) {
        const AttBlk nb_ = att_blk(BLK, t0, L); const int w_ = tid0 >> 6, lr_ = tid0 & 15, lg_ = (tid0 >> 4) & 3;
        const unsigned qo_ = (unsigned)((nb_.r + nb_.d * (nb_.qi0 + 16 * w_ + lr_)) * HD + 8 * lg_) * 2u;
#pragma unroll
        for (int ks = 0; ks < 4; ++ks) qw[ks] = *(const GAS v4u*)((const GAS char*)Qp + qo_ + 64 * ks);
    };
    auto att_body = [&](v4u (&kq)[8], v4u (&vq)[8], v4u (&qw)[4], int blk) __attribute__((always_inline)) {
        const AttBlk B = att_blk(blk, t0, L);
        if (blk == 32) __syncthreads();
        int tid = tid0; asm volatile("" : "+v"(tid));
        const int w = tid >> 6, l = tid & 63, lr = l & 15, lg = l >> 4, krow = tid >> 4, kc = tid & 15, jt0 = w & ~1;
        const int off = 128 * (B.b & 1);
        const float sd = slope * (float)B.d;
        bf16x8 qf[4];
#pragma unroll
        for (int ks = 0; ks < 4; ++ks) qf[ks] = __builtin_bit_cast(bf16x8, qw[ks]);
        WG_BARRIER();
#pragma unroll
        for (int p = 0; p < 8; ++p) if (p >= 4 || B.b == 0) { const int slot = (32 * p + krow + off) & 255;
            *(LAS v4u*)(lds + A_K + slot * RS + 16 * kc) = kq[p];
            *(LAS v4u*)(lds + A_V + slot * RSB + 16 * kc) = vq[p]; }
        WG_BARRIER();
        f32x4 sT[10];
#pragma unroll
        for (int t = 0; t < 10; ++t) sT[t] = (f32x4){0.f, 0.f, 0.f, 0.f};
#pragma unroll
        for (int ks = 0; ks < 4; ++ks) {
#pragma unroll
            for (int t = 0; t < 10; ++t) { const int rowb = (16 * (jt0 + t) + off) & 255;
                const bf16x8 a = *(const LAS bf16x8*)(lds + A_K + (rowb + lr) * RS + (8 * lg + 32 * ks) * 2); sT[t] = MFMA16(a, qf[ks], sT[t]);
                if (t == 4) __builtin_amdgcn_sched_barrier(0); }
            __builtin_amdgcn_sched_barrier(0); }
        if (blk + 1 < 48) att_load_q(qw, blk + 1);
        float lsum = 0.f;
        {
          const int i = 16 * w + lr, rb = 16 * jt0 + 4 * lg - 64 - i, lo_i = -(i + B.qi0), hi_i = B.m - 1 - i - B.qi0;
          const float rbf = (float)rb, LO = (float)(lo_i > -64 ? lo_i : -64), HI = (float)(hi_i < 64 ? hi_i : 64);
          const float L2E = 1.4426950408889634f, sdl = sd * L2E, sml = smax * L2E;
#pragma unroll
          for (int t = 0; t < 10; ++t)
#pragma unroll
            for (int rr = 0; rr < 4; ++rr) { const float relf = rbf + (float)(16 * t + rr);
                const float x = __builtin_fmaf(sT[t][rr], L2E, __builtin_fmaf(-sdl, __builtin_fabsf(relf), -sml));
                const bool ok = __builtin_amdgcn_fmed3f(relf, LO, HI) == relf;
                const float p = ok ? __builtin_amdgcn_exp2f(x) : 0.f; sT[t][rr] = p; lsum += p; } }
        bf16x8 pt[5];
#pragma unroll
        for (int k = 0; k < 5; ++k) { v4u o; o.x = pk2(sT[2 * k][0], sT[2 * k][1]); o.y = pk2(sT[2 * k][2], sT[2 * k][3]); o.z = pk2(sT[2 * k + 1][0], sT[2 * k + 1][1]); o.w = pk2(sT[2 * k + 1][2], sT[2 * k + 1][3]); pt[k] = __builtin_bit_cast(bf16x8, o); }
        f32x4 o[8];
        { LAS unsigned char* trp = lds + A_V + (4 * lg + ((l & 15) >> 2)) * RSB + (l & 3) * 8;
#pragma unroll
          for (int e = 0; e < 8; ++e) o[e] = (f32x4){0.f, 0.f, 0.f, 0.f};
#pragma unroll
          for (int k = 0; k < 5; ++k) { const int rowb = (16 * jt0 + 32 * k + off) & 255;
#pragma unroll
            for (int e = 0; e < 8; ++e) { const bf16x8 vf = ds_tr2(trp + rowb * RSB + (16 * e) * 2, RSB); o[e] = MFMA16(vf, pt[k], o[e]);
                if (e == 3) __builtin_amdgcn_sched_barrier(0); }
            __builtin_amdgcn_sched_barrier(0); } }
        lsum += __shfl_xor(lsum, 16); lsum += __shfl_xor(lsum, 32);
        const int row = rowbase + B.r + B.d * (B.qi0 + 16 * w + lr);
        if (B.dsh != 0) {
            const int pb = B.dsh == 4 ? 0 : 1;
            bf16* op = OP + ((size_t)pb * M + row) * 2048 + h * HD + 4 * lg;
#pragma unroll
            for (int e = 0; e < 8; ++e) { v2u ov; ov.x = pk2(o[e][0], o[e][1]); ov.y = pk2(o[e][2], o[e][3]); *(GAS v2u*)(op + 16 * e) = ov; }
            if (lg == 0) LP[((size_t)pb * NH + h) * M + row] = lsum;
        } else {
            const bf16* p0 = OP + ((size_t)0 * M + row) * 2048 + h * HD + 4 * lg; const bf16* p1 = OP + ((size_t)1 * M + row) * 2048 + h * HD + 4 * lg;
            v2u pa[8], pc[8];
#pragma unroll
            for (int e = 0; e < 8; ++e) { pa[e] = *(const GAS v2u*)(p0 + 16 * e); pc[e] = *(const GAS v2u*)(p1 + 16 * e); }
            const float inv = __builtin_amdgcn_rcpf(lsum + LP[((size_t)0 * NH + h) * M + row] + LP[((size_t)1 * NH + h) * M + row]);
            bf16* mp = MIX + (size_t)row * D + 2048 + h * HD + 4 * lg;
#pragma unroll
            for (int e = 0; e < 8; ++e) { const v2u a = pa[e], c = pc[e];
                v2u ov; ov.x = pk2((o[e][0] + bf_lo(a.x) + bf_lo(c.x)) * inv, (o[e][1] + bf_hi(a.x) + bf_hi(c.x)) * inv); ov.y = pk2((o[e][2] + bf_lo(a.y) + bf_lo(c.y)) * inv, (o[e][3] + bf_hi(a.y) + bf_hi(c.y)) * inv);
                *(GAS v2u*)(mp + 16 * e) = ov; }
        }
    };
    v4u kA[8], vA[8], kB[8], vB[8], qW[4];
    att_load(kA, vA, 0); att_load_q(qW, 0);
    _Pragma("nounroll") for (int blk = 0; blk < 48; blk += 2) {
        att_load(kB, vB, blk + 1);
        att_body(kA, vA, qW, blk);
        if (blk + 2 < 48) att_load(kA, vA, blk + 2);
        att_body(kB, vB, qW, blk + 1);
    }
    __syncthreads();
}

#ifndef PHMASK
#define PHMASK 0x3FF
#endif
#ifndef NLAYER
#define NLAYER 2
#endif
#ifndef DUPMASK
#define DUPMASK 0
#endif
struct Args { const float* in[18]; float* out; unsigned char* ws; };
typedef __attribute__((address_space(4))) const Args CArgs;
__device__ __forceinline__ CArgs* kargs() { CArgs* p = (CArgs*)__builtin_amdgcn_kernarg_segment_ptr(); asm volatile("" : "+s"(p)); return p; }
#define PHASE_PROLOG() CArgs* ka = kargs(); unsigned char* ws = ka->ws; (void)ws; const int tid = opaque_tid(), lane = tid & 63, wave = __builtin_amdgcn_readfirstlane(tid >> 6), gw = vcu * NWAVES + wave; (void)lane; (void)gw
__global__ void __launch_bounds__(NWAVES * 64, 2) fwd_kernel(Args args_unused) {
    extern __shared__ __attribute__((aligned(16))) unsigned char lds_raw[];
    LAS unsigned char* lds = (LAS unsigned char*)lds_raw;
    volatile LAS unsigned* MISC = (volatile LAS unsigned*)(lds + MISC_OFF);
#define G ((int)gridDim.x)
#define bx ((int)blockIdx.x)
#define vcu ((G % 8 == 0) ? (bx % 8) * (G / 8) + bx / 8 : bx)
#define NGW (G * NWAVES)
    for (int u = threadIdx.x; u < (LDS_BYTES - LDSCTL_OFF) / 4; u += NWAVES * 64) ((LAS unsigned*)(lds + LDSCTL_OFF))[u] = 0u;
    __syncthreads();
    (void)xcd_barrier_post((unsigned*)(args_unused.ws + WS_CTL) + CW_BAR, MISC + 8);
#define GRID_BARRIER() do { XcdBarrier b_; b_.bar = (unsigned*)(kargs()->ws + WS_CTL) + CW_BAR; b_.x = xb_xcc_id(); b_.st = (volatile LAS unsigned*)(lds + MISC_OFF) + 8; xcd_barrier(b_); } while (0)

    _Pragma("nounroll") for (int layer = 0; layer < NLAYER; ++layer) {
        if (layer == 0) {
            { PHASE_PROLOG();
              for (int ll = 0; ll < NLAYER; ++ll) { CV_PTRS(P, ka, ws, ll); unsigned* cmi = (unsigned*)(ws + WS_CMAXI) + (size_t)ll * NIN;
                  for (int it = gw; it < 64 * 16; it += NGW) { const int kb = it >> 4, cb = it & 15, n0 = (cb < 8 ? COL_RV : COL_AV - 2048) + 256 * cb; colmax_wide(P.w_in, NIN, P.g_mix, 64 * kb, n0, cmi, lane); } }
              const float* x0 = ka->in[0]; const float* x1 = ka->in[1]; pg8::u64_t* SS = (pg8::u64_t*)(ws + WS_SS); bf16* XB = (bf16*)(ws + WS_U); signed char* XQ = (signed char*)(ws + WS_XQ); float* RA = (float*)(ws + WS_RA);
              for (int m = gw; m < M; m += NGW) x_row_in(m < 8192 ? x0 + (size_t)m * D : x1 + (size_t)(m - 8192) * D, XB + (size_t)m * D, SS + m, XQ + (size_t)m * D, RA + m, lane); }
            GRID_BARRIER();
        }
        {
            PHASE_PROLOG();
            bf16* Pbf = (bf16*)(ws + WS_PBF);
            LAS float* scr = (LAS float*)(lds + wave * TR_SCR);
            { CV_PTRS(P, ka, ws, layer);
              for (int it = gw; it < CV_A; it += NGW) convert_item(P, it, scr, lane);
              unsigned* cm = (unsigned*)(ws + WS_CMAX) + (size_t)layer * NGU;
              { constexpr int NB = DFF / 256, NI = 64 * NB;
                for (int it = gw; it < 2 * NI; it += NGW) { const int r = it < NI ? it : it - NI; const int kb = r / NB, n0 = 256 * (r % NB);
                    colmax_wide(it < NI ? P.w_gate : P.w_up, DFF, P.g_ffn, 64 * kb, n0, cm + (it < NI ? 0 : DFF), lane); } }
              unsigned* cmp_ = (unsigned*)(ws + WS_CMAXP) + (size_t)layer * D;
              for (int it = gw; it < 64 * (D / 256); it += NGW) { const int kb = it / (D / 256), n0 = 256 * (it % (D / 256)); colmax_wide(P.w_pg, D, P.g_ple, 64 * kb, n0, cmp_, lane); } }
            { const float* pp0 = ka->in[2] + (size_t)layer * 8192 * PLE; const float* pp1 = ka->in[3] + (size_t)layer * 8192 * PLE;
              for (int i = bx * 512 + tid; i < M * PLE / 4; i += G * 512) { const int e = 4 * i; const float* src = e < 8192 * PLE ? pp0 + e : pp1 + (e - 8192 * PLE);
                  const f32x4 v = __builtin_nontemporal_load((const GAS f32x4*)src); v2u o; o.x = pk2(v.x, v.y); o.y = pk2(v.z, v.w); *(GAS v2u*)(Pbf + e) = o; } }
            if (layer > 0) { const bf16* XBs = (const bf16*)(ws + WS_XB2); signed char* XQ = (signed char*)(ws + WS_XQ); float* RA = (float*)(ws + WS_RA);
                quant_pass(XBs, XQ, RA, gw, NGW, lane); }
        }
        GRID_BARRIER();
        { CArgs* ka = kargs(); unsigned char* ws = ka->ws; pg8::Gemm g{(bf16*)(ws + WS_XQ), (bf16*)(ws + WS_WINQ), M, D, D / 2}; pg8::StaticOrder S; S.init(M, D, G, bx);
          pg8::EpiStoreHeadsQ E{(bf16*)(ws + WS_Z), M, (const float*)(ws + WS_RA), (const float*)(ws + WS_DBI)};
          pg8::gemm_phase<pg8::EpiStoreHeadsQ, pg8::StaticOrder, true, true, true>(lds, g, S, E); }
        { CArgs* ka = kargs(); unsigned char* ws = ka->ws; pg8::Gemm g{(bf16*)(ws + (layer == 0 ? WS_U : WS_XB2)), (bf16*)(ws + WS_WIN), M, NIN - D, D}; pg8::StaticOrder S; S.init(M, NIN - D, G, bx);
          pg8::EpiStoreHeads E{(bf16*)(ws + WS_Z), M, (const pg8::u64_t*)(ws + WS_SS) + (size_t)(layer * 3 + 0) * M, ka->in[8] + (size_t)layer * HD, ka->in[9] + (size_t)layer * HD, (LAS float*)(lds + 131072)};
          pg8::gemm_phase<pg8::EpiStoreHeads, pg8::StaticOrder, true, true>(lds, g, S, E); }
        GRID_BARRIER();
        for (int rep = 0; rep < ((DUPMASK & 8) ? 2 : 1); ++rep)
        for (int item = bx; item < 128 + 128; item += G) {
            PHASE_PROLOG();
            const bf16* Z = (const bf16*)(ws + WS_Z); bf16* MIX = (bf16*)(ws + WS_MIX);
            if (item < 128) retention_item(lds, Z, (bf16*)(ws + WS_YF), MIX, ka->in[6] + (size_t)layer * 2 * NH, ka->in[7] + (size_t)layer * 2048, (unsigned long long*)(ws + WS_EXP), (unsigned*)(ws + WS_CTL) + CW_FLAG + 4096 * layer, item, tid);
            else attention_item(lds, Z, (bf16*)(ws + WS_OP), (float*)(ws + WS_LP), MIX, ka->in[8] + (size_t)layer * HD, ka->in[9] + (size_t)layer * HD, item - 128, tid);
        }
        {
            PHASE_PROLOG();
            LAS float* scr = (LAS float*)(lds + wave * TR_SCR);
            unsigned* qhead = (unsigned*)(ws + WS_CTL) + CW_QUEUE + 64 * layer;
            CV_PTRS(P, ka, ws, layer);
            volatile LAS unsigned* qb = (volatile LAS unsigned*)(lds + MISC_OFF) + 2;
            for (;;) {
                __syncthreads();
                if (tid == 0) *qb = atomicAdd(qhead, 32u);
                __syncthreads();
                const int it0 = CV_A + (int)__builtin_amdgcn_readfirstlane(*qb);
                if (it0 >= CV_ALL) break;
                for (int k = 0; k < 4; ++k) { const int it = it0 + 8 * k + wave; if (it < CV_ALL) convert_item(P, it, scr, lane); }
            }
        }
        GRID_BARRIER();
        { CArgs* ka = kargs(); unsigned char* ws = ka->ws; pg8::Gemm g{(bf16*)(ws + WS_MIX), (bf16*)(ws + WS_WOUT), M, D, D}; pg8::StaticOrder S; S.init(M, D, G, bx);
          pg8::EpiResAdd E{(bf16*)(ws + (layer == 0 ? WS_U : WS_XB2)), D};
          pg8::gemm_phase<pg8::EpiResAdd, pg8::StaticOrder, true, true>(lds, g, S, E); }
        GRID_BARRIER();
        { PHASE_PROLOG(); const bf16* XBs = (const bf16*)(ws + (layer == 0 ? WS_U : WS_XB2)); signed char* XQ = (signed char*)(ws + WS_XQ); float* RA = (float*)(ws + WS_RA);
          quant_pass(XBs, XQ, RA, gw, NGW, lane); }
        GRID_BARRIER();
        for (int rep = 0; rep < ((DUPMASK & 64) ? 2 : 1); ++rep)
        { CArgs* ka = kargs(); unsigned char* ws = ka->ws; pg8::Gemm g{(bf16*)(ws + WS_XQ), (bf16*)(ws + WS_WGU), M, NGU, D / 2}; pg8::StaticOrder S; S.init(M, NGU, G, bx);
          pg8::EpiSwiGLUQ E{(bf16*)(ws + WS_Z), DFF, (const float*)(ws + WS_RA), (const float*)(ws + WS_DB)};
          pg8::gemm_phase<pg8::EpiSwiGLUQ, pg8::StaticOrder, true, true, true>(lds, g, S, E); }
        { constexpr int NU_F = (M / 256) * (NGU / 256); const int heavy = NU_F % G;
          { CArgs* ka = kargs(); unsigned char* ws = ka->ws; int Kp = PLE; asm volatile("" : "+s"(Kp)); pg8::Gemm g{(bf16*)(ws + WS_PBF), (bf16*)(ws + WS_WPP), M, D, Kp}; pg8::StaticOrder S; pg8::EpiStoreBf16 E{(bf16*)(ws + WS_PP), D};
            if (heavy > 0 && heavy < G) { const int npp = (M / 256) * (D / 256), cut = (npp * 3 / 4) / (G - heavy) * (G - heavy);
                if (bx >= heavy) { S.init(M, D, G - heavy, bx - heavy); S.lim = cut; } else { S.init(M, D, heavy, bx); S.base = cut; } }
            else S.init(M, D, G, bx);
            pg8::gemm_phase<pg8::EpiStoreBf16, pg8::StaticOrder, true, true>(lds, g, S, E); } }
        GRID_BARRIER();
        { CArgs* ka = kargs(); unsigned char* ws = ka->ws; pg8::Gemm g{(bf16*)(ws + WS_Z), (bf16*)(ws + WS_WDN), M, D, DFF}; pg8::StaticOrder S; S.init(M, D, G, bx);
          pg8::EpiResAdd E{(bf16*)(ws + (layer == 0 ? WS_U : WS_XB2)), D};
          pg8::gemm_phase<pg8::EpiResAdd, pg8::StaticOrder, true, true>(lds, g, S, E); }
        GRID_BARRIER();
        { PHASE_PROLOG(); const bf16* XBs = (const bf16*)(ws + (layer == 0 ? WS_U : WS_XB2)); signed char* XQ = (signed char*)(ws + WS_XQ); float* RA = (float*)(ws + WS_RA);
          quant_pass(XBs, XQ, RA, gw, NGW, lane); }
        GRID_BARRIER();
        if (PHMASK & 256)
        { CArgs* ka = kargs(); unsigned char* ws = ka->ws; const bf16* sb = (const bf16*)(ws + (layer == 0 ? WS_U : WS_XB2)); pg8::Gemm g{(bf16*)(ws + WS_XQ), (bf16*)(ws + WS_WPG), M, D, D / 2}; pg8::StaticOrder S; S.init(M, D, G, bx);
          pg8::EpiPleT<true> E{sb, (const bf16*)(ws + WS_PP), (bf16*)(ws + WS_XB2), nullptr, (const float*)(ws + WS_RA), (const float*)(ws + WS_DBP), (pg8::u64_t*)(ws + WS_SS) + (size_t)((layer * 3 + 3) % 6) * M, layer == NLAYER - 1 ? ka->out : nullptr, D};
          pg8::gemm_phase<pg8::EpiPleT<true>, pg8::StaticOrder, true, true, true>(lds, g, S, E); }
        GRID_BARRIER();
    }
}

#undef G
#undef bx
#undef vcu
#undef NGW
#undef GRID_BARRIER
extern "C" void kernel_launch(void* const* d_in, const int* in_sizes, int n_in, void* d_out, int out_size, void* d_ws, size_t ws_size, hipStream_t stream) {
    static int grid = 0;
    if (grid == 0) {
        if (n_in != 18 || out_size != M * D || ws_size < WS_END) { fprintf(stderr, "kernel_launch: unexpected shapes: n_in %d out %d ws %zu (need %zu)\n", n_in, out_size, ws_size, (size_t)WS_END); grid = -1; return; }
        int dev = 0, cus = 0, per_cu = 0;
        if (hipGetDevice(&dev) != hipSuccess || hipDeviceGetAttribute(&cus, hipDeviceAttributeMultiprocessorCount, dev) != hipSuccess) { grid = -1; return; }
        if (hipFuncSetAttribute((const void*)fwd_kernel, hipFuncAttributeMaxDynamicSharedMemorySize, LDS_BYTES) != hipSuccess) { fprintf(stderr, "kernel_launch: hipFuncSetAttribute failed\n"); grid = -1; return; }
        if (hipOccupancyMaxActiveBlocksPerMultiprocessor(&per_cu, (const void*)fwd_kernel, NWAVES * 64, LDS_BYTES) != hipSuccess || per_cu < 1) fprintf(stderr, "kernel_launch: occupancy query says %d\n", per_cu);
        (void)hipGetLastError();
        grid = cus;
    }
    if (grid < 0) return;
    if (hipMemsetAsync((char*)d_ws + WS_CTL, 0, CTL_ZERO_BYTES, stream) != hipSuccess) return;
    Args a{};
    for (int i = 0; i < 18; ++i) a.in[i] = (const float*)d_in[i];
    a.out = (float*)d_out; a.ws = (unsigned char*)d_ws;
    hipLaunchKernelGGL(fwd_kernel, dim3(grid), dim3(NWAVES * 64), LDS_BYTES, stream, a);
}
```

```cpp
#include <hip/hip_runtime.h>
#include <cstdio>
#include <cstdint>

__device__ __forceinline__ int opaque_tid() { int t = threadIdx.x; asm volatile("" : "+v"(t)); return t; }
template <class T> __device__ __forceinline__ T* opaque_ptr(T* p) { asm volatile("" : "+s"(p)); return p; }
namespace pg8 {
#define PG8_LAS __attribute__((address_space(3)))
typedef unsigned short bf16_t;
typedef short bf16x8 __attribute__((ext_vector_type(8)));
typedef float f32x4 __attribute__((ext_vector_type(4)));
typedef int i32x4 __attribute__((ext_vector_type(4)));
typedef unsigned u32x4 __attribute__((ext_vector_type(4)));
typedef unsigned u32x2 __attribute__((ext_vector_type(2)));
constexpr int BM = 256, BK = 64, HALF = 128, HTB = HALF * BK * 2, STAGE_BYTES = 8 * HTB, NXCD = 8, WGM = 8;

__host__ __device__ __forceinline__ int lds_byte(int r, int c) { const int st = (r >> 4) * 2 + (c >> 5), rr = r & 15, cc = c & 31, ob = rr * 64 + cc * 2; return st * 1024 + (ob ^ (((ob >> 9) & 1) << 5)); }
__host__ __device__ __forceinline__ void stage_rc(int b, int& R, int& C) { const int st = b / 1024, sb = b % 1024, swz = sb ^ (((sb >> 9) & 1) << 5); R = (st >> 1) * 16 + swz / 64; C = (st & 1) * 32 + (swz % 64) / 2; }
__host__ __device__ __forceinline__ int perm32(int rho) { const int n = rho >> 4, i = rho & 15; return 8 * (i >> 2) + 4 * n + (i & 3); }

struct Unit { int pm, pn; };
struct Gemm { const bf16_t* A; const bf16_t* Bt; int M, N, K; };

struct StaticOrder {
    int nM, nN, nwg, G, c, base, lim;
    __host__ __device__ void init(int M, int N, int G_, int c_) { nM = M / BM; nN = N / BM; nwg = nM * nN; G = G_; c = c_; base = 0; lim = nwg; }
    __host__ __device__ bool next(int i, Unit& u) const {
        const long L = (long)base + (long)i * G + c; if (L >= lim) return false;
        int wgid = (int)L; { const int q = nwg / NXCD, r = nwg % NXCD, xcd = wgid % NXCD, off = wgid / NXCD; wgid = (xcd < r ? xcd * (q + 1) : r * (q + 1) + (xcd - r) * q) + off; }
        const int nig = WGM * nN, gid = wgid / nig, fm = gid * WGM, gsz = (nM - fm) < WGM ? (nM - fm) : WGM;
        u.pm = fm + ((wgid % nig) % gsz); u.pn = (wgid % nig) / gsz; return true;
    }
    __device__ __forceinline__ void a_ready(const Unit&) const {}
    __device__ __forceinline__ void done(const Unit&) const {}
};

__device__ __forceinline__ unsigned cvt_pk_bf16(float lo, float hi) { unsigned r; asm volatile("v_cvt_pk_bf16_f32 %0, %1, %2" : "=v"(r) : "v"(lo), "v"(hi)); return r; }
__device__ __forceinline__ float fast_sigmoid(float x) { return __builtin_amdgcn_rcpf(1.0f + __expf(-x)); }

struct EpiStoreBf16 {
    static constexpr bool PERM = true, AFTER_DRAIN = false;
    bf16_t* O; int ldc;
    __device__ __forceinline__ void operator()(const f32x4 (&acc)[2][2][4][2], const Unit& u, int wr, int wc, int fr, int fq) const {
        const int row0 = u.pm * BM + wr * 64 + fr, col0 = u.pn * BM + wc * 32 + 8 * fq;
#pragma unroll
        for (int ai = 0; ai < 2; ++ai)
#pragma unroll
            for (int m = 0; m < 4; ++m) { bf16_t* rowp = O + (size_t)(row0 + ai * HALF + m * 16) * ldc + col0;
#pragma unroll
                for (int bj = 0; bj < 2; ++bj) { const f32x4 v0 = acc[ai][bj][m][0], v1 = acc[ai][bj][m][1];
                    u32x4 w; w.x = cvt_pk_bf16(v0[0], v0[1]); w.y = cvt_pk_bf16(v0[2], v0[3]); w.z = cvt_pk_bf16(v1[0], v1[1]); w.w = cvt_pk_bf16(v1[2], v1[3]);
                    *(u32x4*)(rowp + bj * HALF) = w; } }
    }
};
typedef unsigned long long u64_t;
__device__ __forceinline__ u64_t ss_fix(float ss) { return (u64_t)(ss * 1048576.0f + 0.5f); }
__device__ __forceinline__ float ss_rs(u64_t v) { return 1.0f / sqrtf((float)v * (1.0f / (1048576.0f * 4096.0f)) + 1e-6f); }
__device__ __forceinline__ float row_rs(const u64_t* SS, int row) { return ss_rs(SS[row]); }
struct EpiStoreHeads {
    static constexpr bool PERM = true, AFTER_DRAIN = false;
    bf16_t* O; int Mrows; const u64_t* SS; const float* qg; const float* kg; PG8_LAS float* T;
    __device__ __forceinline__ void operator()(const f32x4 (&acc)[2][2][4][2], const Unit& u, int wr, int wc, int fr, int fq) const {
        const int row0 = u.pm * BM + wr * 64 + fr, col0 = wc * 32 + 8 * fq;
        const bool qk = 2 * u.pn >= 32;
        float rsv[2][4];
        { u64_t ssv[2][4];
#pragma unroll
          for (int ai = 0; ai < 2; ++ai)
#pragma unroll
              for (int m = 0; m < 4; ++m) ssv[ai][m] = SS[row0 + ai * HALF + m * 16];
          __builtin_amdgcn_sched_barrier(0);
#pragma unroll
          for (int ai = 0; ai < 2; ++ai)
#pragma unroll
              for (int m = 0; m < 4; ++m) rsv[ai][m] = __builtin_amdgcn_rsqf((float)ssv[ai][m] * (1.0f / (1048576.0f * 4096.0f)) + 1e-6f); }
        if (qk) {
            float sp[2][4][2];
#pragma unroll
            for (int ai = 0; ai < 2; ++ai)
#pragma unroll
                for (int m = 0; m < 4; ++m) { const float rs = rsv[ai][m];
#pragma unroll
                    for (int bj = 0; bj < 2; ++bj) { const f32x4 v0 = acc[ai][bj][m][0] * rs, v1 = acc[ai][bj][m][1] * rs;
                        sp[ai][m][bj] = ((v0[0] * v0[0] + v0[1] * v0[1]) + (v0[2] * v0[2] + v0[3] * v0[3])) + ((v1[0] * v1[0] + v1[1] * v1[1]) + (v1[2] * v1[2] + v1[3] * v1[3])); } }
            float t1[2][4][2];
#pragma unroll
            for (int ai = 0; ai < 2; ++ai)
#pragma unroll
                for (int m = 0; m < 4; ++m)
#pragma unroll
                    for (int bj = 0; bj < 2; ++bj) t1[ai][m][bj] = __shfl_xor(sp[ai][m][bj], 16);
#pragma unroll
            for (int ai = 0; ai < 2; ++ai)
#pragma unroll
                for (int m = 0; m < 4; ++m)
#pragma unroll
                    for (int bj = 0; bj < 2; ++bj) sp[ai][m][bj] += t1[ai][m][bj];
#pragma unroll
            for (int ai = 0; ai < 2; ++ai)
#pragma unroll
                for (int m = 0; m < 4; ++m)
#pragma unroll
                    for (int bj = 0; bj < 2; ++bj) t1[ai][m][bj] = __shfl_xor(sp[ai][m][bj], 32);
            if (fq == 0) {
#pragma unroll
                for (int ai = 0; ai < 2; ++ai)
#pragma unroll
                    for (int m = 0; m < 4; ++m) { const int rt = ai * HALF + wr * 64 + m * 16 + fr;
#pragma unroll
                        for (int bj = 0; bj < 2; ++bj) T[(rt * 2 + bj) * 4 + wc] = sp[ai][m][bj] + t1[ai][m][bj]; } }
            asm volatile("s_waitcnt lgkmcnt(0)" ::: "memory"); __builtin_amdgcn_s_barrier(); asm volatile("" ::: "memory");
        }
        const bool isq = 2 * u.pn < 48;
        const float* gp = (isq ? qg : kg) + col0; const float sc = isq ? 0.08838834764831845f : 1.0f;
        f32x4 g0 = (f32x4){1.f, 1.f, 1.f, 1.f}, g1 = g0;
        if (qk) { g0 = *(const f32x4*)gp; g1 = *(const f32x4*)(gp + 4); }
#pragma unroll
        for (int ai = 0; ai < 2; ++ai)
#pragma unroll
            for (int m = 0; m < 4; ++m) { const int row = row0 + ai * HALF + m * 16; const float rs = rsv[ai][m]; const int rt = ai * HALF + wr * 64 + m * 16 + fr;
#pragma unroll
                for (int bj = 0; bj < 2; ++bj) { f32x4 v0 = acc[ai][bj][m][0] * rs, v1 = acc[ai][bj][m][1] * rs;
                    if (qk) { const f32x4 t = *(const PG8_LAS f32x4*)(T + (rt * 2 + bj) * 4);
                        const float rn = __builtin_amdgcn_rsqf(((t[0] + t[1]) + (t[2] + t[3])) * (1.f / 128.f) + 1e-6f) * sc;
                        v0 = (v0 * rn) * g0; v1 = (v1 * rn) * g1; }
                    u32x4 w; w.x = cvt_pk_bf16(v0[0], v0[1]); w.y = cvt_pk_bf16(v0[2], v0[3]); w.z = cvt_pk_bf16(v1[0], v1[1]); w.w = cvt_pk_bf16(v1[2], v1[3]);
                    const int pc = 2 * u.pn + bj, pl = pc + (pc < 16 ? 16 : 32);
                    *(u32x4*)(O + ((size_t)pl * Mrows + row) * HALF + col0) = w; } }
    }
};
struct EpiStoreHeadsQ {
    static constexpr bool PERM = true, AFTER_DRAIN = false;
    bf16_t* O; int Mrows; const float* RA; const float* DB;
    __device__ __forceinline__ void operator()(const i32x4 (&acc)[2][2][4][2], const Unit& u, int wr, int wc, int fr, int fq) const {
        const int row0 = u.pm * BM + wr * 64 + fr, col0 = wc * 32 + 8 * fq, bcol = u.pn * BM + wc * 32 + 8 * fq;
        f32x4 db[2][2];
#pragma unroll
        for (int bj = 0; bj < 2; ++bj) { db[bj][0] = *(const f32x4*)(DB + bcol + bj * HALF); db[bj][1] = *(const f32x4*)(DB + bcol + bj * HALF + 4); }
        float rav[2][4];
#pragma unroll
        for (int ai = 0; ai < 2; ++ai)
#pragma unroll
            for (int m = 0; m < 4; ++m) rav[ai][m] = RA[row0 + ai * HALF + m * 16];
        __builtin_amdgcn_sched_barrier(0);
#pragma unroll
        for (int ai = 0; ai < 2; ++ai)
#pragma unroll
            for (int m = 0; m < 4; ++m) { const int row = row0 + ai * HALF + m * 16; const float ra = rav[ai][m];
#pragma unroll
                for (int bj = 0; bj < 2; ++bj) { float v[8];
#pragma unroll
                    for (int j = 0; j < 4; ++j) { v[j] = (float)acc[ai][bj][m][0][j] * ra * db[bj][0][j]; v[4 + j] = (float)acc[ai][bj][m][1][j] * ra * db[bj][1][j]; }
                    u32x4 w; w.x = cvt_pk_bf16(v[0], v[1]); w.y = cvt_pk_bf16(v[2], v[3]); w.z = cvt_pk_bf16(v[4], v[5]); w.w = cvt_pk_bf16(v[6], v[7]);
                    const int pc = 2 * u.pn + bj, pl = pc < 16 ? pc : (pc < 32 ? 16 + pc : 64 + pc);
                    *(u32x4*)(O + ((size_t)pl * Mrows + row) * HALF + col0) = w; } }
    }
};
__device__ __forceinline__ void unpack8(const u32x4 w, f32x4& a, f32x4& b) { a[0] = __uint_as_float(w.x << 16); a[1] = __uint_as_float(w.x & 0xffff0000u); a[2] = __uint_as_float(w.y << 16); a[3] = __uint_as_float(w.y & 0xffff0000u);
    b[0] = __uint_as_float(w.z << 16); b[1] = __uint_as_float(w.z & 0xffff0000u); b[2] = __uint_as_float(w.w << 16); b[3] = __uint_as_float(w.w & 0xffff0000u); }
struct EpiResAdd {
    static constexpr bool PERM = true, AFTER_DRAIN = false;
    bf16_t* XB; int ldc;
    __device__ __forceinline__ void operator()(const f32x4 (&acc)[2][2][4][2], const Unit& u, int wr, int wc, int fr, int fq) const {
        const int row0 = u.pm * BM + wr * 64 + fr, col0 = u.pn * BM + wc * 32 + 8 * fq;
        u32x4 xv[2][4][2];
#pragma unroll
        for (int ai = 0; ai < 2; ++ai)
#pragma unroll
            for (int m = 0; m < 4; ++m)
#pragma unroll
                for (int bj = 0; bj < 2; ++bj) xv[ai][m][bj] = *(const u32x4*)(XB + (size_t)(row0 + ai * HALF + m * 16) * ldc + col0 + bj * HALF);
#pragma unroll
        for (int ai = 0; ai < 2; ++ai) {
#pragma unroll
            for (int m = 0; m < 4; ++m) { const int row = row0 + ai * HALF + m * 16;
#pragma unroll
                for (int bj = 0; bj < 2; ++bj) { f32x4 v0, v1; unpack8(xv[ai][m][bj], v0, v1); v0 = v0 + acc[ai][bj][m][0]; v1 = v1 + acc[ai][bj][m][1];
                    u32x4 w; w.x = cvt_pk_bf16(v0[0], v0[1]); w.y = cvt_pk_bf16(v0[2], v0[3]); w.z = cvt_pk_bf16(v1[0], v1[1]); w.w = cvt_pk_bf16(v1[2], v1[3]);
                    *(u32x4*)(XB + (size_t)row * ldc + col0 + bj * HALF) = w; } }
            asm volatile("" ::: "memory"); }
    }
};
struct EpiSwiGLUQ {
    static constexpr bool PERM = true, AFTER_DRAIN = false;
    bf16_t* H; int ldh; const float* RA; const float* DB;
    __device__ __forceinline__ void operator()(const i32x4 (&acc)[2][2][4][2], const Unit& u, int wr, int wc, int fr, int fq) const {
        const int row0 = u.pm * BM + wr * 64 + fr, col0 = u.pn * HALF + wc * 32 + 8 * fq, brow = u.pn * BM + wc * 32 + 8 * fq;
        const f32x4 dg0 = *(const f32x4*)(DB + brow), dg1 = *(const f32x4*)(DB + brow + 4), du0 = *(const f32x4*)(DB + brow + HALF), du1 = *(const f32x4*)(DB + brow + HALF + 4);
        float rav[2][4];
#pragma unroll
        for (int ai = 0; ai < 2; ++ai)
#pragma unroll
            for (int m = 0; m < 4; ++m) rav[ai][m] = RA[row0 + ai * HALF + m * 16];
        __builtin_amdgcn_sched_barrier(0);
#pragma unroll
        for (int ai = 0; ai < 2; ++ai)
#pragma unroll
            for (int m = 0; m < 4; ++m) { const int row = row0 + ai * HALF + m * 16; const float ra = rav[ai][m]; bf16_t* rowp = H + (size_t)row * ldh + col0;
                float hv[8];
#pragma unroll
                for (int j = 0; j < 4; ++j) { const float g0 = (float)acc[ai][0][m][0][j] * ra * dg0[j], u0 = (float)acc[ai][1][m][0][j] * ra * du0[j]; hv[j] = g0 * fast_sigmoid(g0) * u0;
                    const float g1 = (float)acc[ai][0][m][1][j] * ra * dg1[j], u1 = (float)acc[ai][1][m][1][j] * ra * du1[j]; hv[4 + j] = g1 * fast_sigmoid(g1) * u1; }
                u32x4 w; w.x = cvt_pk_bf16(hv[0], hv[1]); w.y = cvt_pk_bf16(hv[2], hv[3]); w.z = cvt_pk_bf16(hv[4], hv[5]); w.w = cvt_pk_bf16(hv[6], hv[7]);
                *(u32x4*)rowp = w; }
    }
};
struct EpiSwiGLU {
    static constexpr bool PERM = true, AFTER_DRAIN = false;
    bf16_t* H; int ldh; const u64_t* SS;
    __device__ __forceinline__ void operator()(const f32x4 (&acc)[2][2][4][2], const Unit& u, int wr, int wc, int fr, int fq) const {
        const int row0 = u.pm * BM + wr * 64 + fr, col0 = u.pn * HALF + wc * 32 + 8 * fq;
#pragma unroll
        for (int ai = 0; ai < 2; ++ai)
#pragma unroll
            for (int m = 0; m < 4; ++m) { const int row = row0 + ai * HALF + m * 16; const float rs = row_rs(SS, row); bf16_t* rowp = H + (size_t)row * ldh + col0;
                float hv[8];
#pragma unroll
                for (int n = 0; n < 2; ++n)
#pragma unroll
                    for (int j = 0; j < 4; ++j) { const float g = acc[ai][0][m][n][j] * rs, up = acc[ai][1][m][n][j] * rs; hv[4 * n + j] = g * fast_sigmoid(g) * up; }
                u32x4 w; w.x = cvt_pk_bf16(hv[0], hv[1]); w.y = cvt_pk_bf16(hv[2], hv[3]); w.z = cvt_pk_bf16(hv[4], hv[5]); w.w = cvt_pk_bf16(hv[6], hv[7]);
                *(u32x4*)rowp = w; }
    }
};
template <bool Q> struct EpiPleT {
    static constexpr bool PERM = true, AFTER_DRAIN = false;
    const bf16_t* XBi; const bf16_t* PP; bf16_t* XBo; const u64_t* SS; const float* RA; const float* DB; u64_t* SSo; float* OUT; int ldc;
    template <class ACC> __device__ __forceinline__ void operator()(const ACC (&acc)[2][2][4][2], const Unit& u, int wr, int wc, int fr, int fq) const {
        const int row0 = u.pm * BM + wr * 64 + fr, col0 = u.pn * BM + wc * 32 + 8 * fq;
        f32x4 db[2][2];
        if constexpr (Q) {
#pragma unroll
            for (int bj = 0; bj < 2; ++bj) { db[bj][0] = *(const f32x4*)(DB + col0 + bj * HALF); db[bj][1] = *(const f32x4*)(DB + col0 + bj * HALF + 4); } }
#pragma unroll
        for (int ai = 0; ai < 2; ++ai)
#pragma unroll
          for (int mp = 0; mp < 2; ++mp) {
            u32x4 xv[2][2], pv[2][2]; float rsv[2];
#pragma unroll
            for (int mm = 0; mm < 2; ++mm) { const int row = row0 + ai * HALF + (2 * mp + mm) * 16; if constexpr (Q) rsv[mm] = RA[row]; else rsv[mm] = ss_rs(SS[row]);
#pragma unroll
                for (int bj = 0; bj < 2; ++bj) { xv[mm][bj] = *(const u32x4*)(XBi + (size_t)row * ldc + col0 + bj * HALF); pv[mm][bj] = *(const u32x4*)(PP + (size_t)row * ldc + col0 + bj * HALF); } }
#pragma unroll
            for (int mm = 0; mm < 2; ++mm) { const int m = 2 * mp + mm, row = row0 + ai * HALF + m * 16; float ss = 0.f; const float rs = rsv[mm];
#pragma unroll
                for (int bj = 0; bj < 2; ++bj) { f32x4 v0, v1, p0, p1; unpack8(xv[mm][bj], v0, v1); unpack8(pv[mm][bj], p0, p1); f32x4 a0, a1;
#pragma unroll
                    for (int j = 0; j < 4; ++j) { if constexpr (Q) { a0[j] = (float)acc[ai][bj][m][0][j] * rs * db[bj][0][j]; a1[j] = (float)acc[ai][bj][m][1][j] * rs * db[bj][1][j]; }
                                                  else { a0[j] = (float)acc[ai][bj][m][0][j] * rs; a1[j] = (float)acc[ai][bj][m][1][j] * rs; } }
#pragma unroll
                    for (int j = 0; j < 4; ++j) { v0[j] += fast_sigmoid(a0[j]) * p0[j]; v1[j] += fast_sigmoid(a1[j]) * p1[j]; }
                    if (OUT) { float* p = OUT + (size_t)row * ldc + col0 + bj * HALF; *(f32x4*)p = v0; *(f32x4*)(p + 4) = v1; }
                    else { u32x4 w; w.x = cvt_pk_bf16(v0[0], v0[1]); w.y = cvt_pk_bf16(v0[2], v0[3]); w.z = cvt_pk_bf16(v1[0], v1[1]); w.w = cvt_pk_bf16(v1[2], v1[3]);
                        *(u32x4*)(XBo + (size_t)row * ldc + col0 + bj * HALF) = w; unpack8(w, v0, v1);
                        ss += ((v0[0] * v0[0] + v0[1] * v0[1]) + (v0[2] * v0[2] + v0[3] * v0[3])) + ((v1[0] * v1[0] + v1[1] * v1[1]) + (v1[2] * v1[2] + v1[3] * v1[3])); } }
                if (!OUT) { ss += __shfl_xor(ss, 16); ss += __shfl_xor(ss, 32); if (fq == 0) atomicAdd(SSo + row, ss_fix(ss)); } }
            asm volatile("" ::: "memory"); }
    }
};

template <bool I8> struct AccT { typedef f32x4 type; }; template <> struct AccT<true> { typedef i32x4 type; };
template <class Epi, class Sched, bool ALIGN_EPI = false, bool SP2 = false, bool I8 = false>
__device__ __forceinline__ void gemm_phase(PG8_LAS unsigned char* lds, const Gemm g, const Sched& S, const Epi& E) {
    const int tid = opaque_tid(), wid = __builtin_amdgcn_readfirstlane(tid >> 6), lane = tid & 63, wr = wid >> 2, wc = wid & 3, fr = lane & 15, fq = lane >> 4;
    const int K = g.K, nt = K / BK;
    unsigned voffA[2], voffB[2];
#pragma unroll
    for (int i = 0; i < 2; ++i) { int R, C; stage_rc(tid * 16 + i * 8192, R, C); const int Rb = Epi::PERM ? ((R & ~31) + perm32(R & 31)) : R;
        voffA[i] = (unsigned)(R * K + C) * 2u; voffB[i] = (unsigned)(Rb * K + C) * 2u; }
    const size_t kstep = (size_t)(BK * 2);
    const size_t hstep = (size_t)HALF * K * 2;
    const size_t tstep = 2 * hstep;
    const unsigned ldsw = (unsigned)wid * 1024u;
    const int aoff = lds_byte(wr * 64 + fr, fq * 8), boff = lds_byte(wc * 32 + fr, fq * 8);
#define PG8_SA(b, h) (((b) * 2 + (h)) * HTB)
#define PG8_SB(b, h) ((4 + (b) * 2 + (h)) * HTB)
#define PG8_STAGE(bufoff, gbase, voff) do { _Pragma("unroll") for (int _i = 0; _i < 2; ++_i) \
        __builtin_amdgcn_global_load_lds((const unsigned*)((const char*)(gbase) + (voff)[_i]), (PG8_LAS unsigned*)(lds + (bufoff) + ldsw + _i * 8192), 16, 0, 0); } while (0)
#define PG8_LDA(dst, b, h) do { _Pragma("unroll") for (int m = 0; m < 4; ++m) _Pragma("unroll") for (int k = 0; k < 2; ++k) dst[m][k] = *(const PG8_LAS bf16x8*)(lds + PG8_SA(b, h) + aoff + m * 2048 + k * 1024); } while (0)
#define PG8_LDB(dst, b, h) do { _Pragma("unroll") for (int n = 0; n < 2; ++n) _Pragma("unroll") for (int k = 0; k < 2; ++k) dst[n][k] = *(const PG8_LAS bf16x8*)(lds + PG8_SB(b, h) + boff + n * 2048 + k * 1024); } while (0)
#define PG8_MMA(ai, bj, At, Bt) do { __builtin_amdgcn_s_setprio(1); _Pragma("unroll") for (int m = 0; m < 4; ++m) _Pragma("unroll") for (int n = 0; n < 2; ++n) _Pragma("unroll") for (int k = 0; k < 2; ++k) { \
        if constexpr (I8) acc[ai][bj][m][n] = __builtin_amdgcn_mfma_i32_16x16x64_i8(__builtin_bit_cast(i32x4, Bt[n][k]), __builtin_bit_cast(i32x4, At[m][k]), acc[ai][bj][m][n], 0, 0, 0); \
        else acc[ai][bj][m][n] = __builtin_amdgcn_mfma_f32_16x16x32_bf16(Bt[n][k], At[m][k], acc[ai][bj][m][n], 0, 0, 0); } __builtin_amdgcn_s_setprio(0); } while (0)
#define PG8_WAIT_V(n) asm volatile("s_waitcnt vmcnt(" #n ")" ::: "memory")
#define PG8_WAIT_L(n) asm volatile("s_waitcnt lgkmcnt(" #n ")" ::: "memory")
#define PG8_BAR __builtin_amdgcn_s_barrier()
#define PG8_SCHED __builtin_amdgcn_sched_barrier(0)
    Unit cur, nxt; int ui = 0;
    if (!S.next(0, cur)) return;
    typedef typename AccT<I8>::type acc_t;
    acc_t acc[2][2][4][2];
#pragma unroll
    for (int a = 0; a < 2; ++a)
#pragma unroll
        for (int b = 0; b < 2; ++b)
#pragma unroll
            for (int m = 0; m < 4; ++m)
#pragma unroll
                for (int n = 0; n < 2; ++n) acc[a][b][m][n] = (acc_t){0, 0, 0, 0};
    bf16x8 At[4][2], B0[2][2], B1[2][2];
    const char* cA = (const char*)g.A + (size_t)cur.pm * tstep; const char* cB = (const char*)g.Bt + (size_t)cur.pn * tstep;
    S.a_ready(cur);
    if constexpr (SP2) {
        PG8_STAGE(PG8_SB(0, 0), cB, voffB); PG8_STAGE(PG8_SB(0, 1), cB + hstep, voffB); PG8_STAGE(PG8_SA(0, 0), cA, voffA); PG8_STAGE(PG8_SA(0, 1), cA + hstep, voffA);
        if (wr == 1) PG8_BAR;
        PG8_WAIT_V(2); PG8_BAR;
        PG8_STAGE(PG8_SB(1, 0), cB + kstep, voffB); PG8_STAGE(PG8_SA(1, 0), cA + kstep, voffA); PG8_STAGE(PG8_SB(1, 1), cB + hstep + kstep, voffB);
        PG8_WAIT_V(6); PG8_BAR;
    } else {
        PG8_STAGE(PG8_SB(0, 0), cB, voffB); PG8_STAGE(PG8_SA(0, 0), cA, voffA); PG8_STAGE(PG8_SB(0, 1), cB + hstep, voffB); PG8_STAGE(PG8_SA(0, 1), cA + hstep, voffA);
        if (wr == 1) PG8_BAR;
        PG8_WAIT_V(4); PG8_BAR;
        PG8_STAGE(PG8_SB(1, 0), cB + kstep, voffB); PG8_STAGE(PG8_SA(1, 0), cA + kstep, voffA); PG8_STAGE(PG8_SB(1, 1), cB + hstep + kstep, voffB);
        PG8_WAIT_V(6); PG8_BAR;
    }
    for (;;) {
        const bool has_next = S.next(ui + 1, nxt);
        const char* nA = has_next ? (const char*)g.A + (size_t)nxt.pm * tstep : cA; const char* nB = has_next ? (const char*)g.Bt + (size_t)nxt.pn * tstep : cB;
        for (int t = 0; t < nt; t += 2) {
            const bool last = (t == nt - 2);
            const char* a1 = cA + (size_t)(t + 1) * kstep;
            const char* a2 = last ? nA : cA + (size_t)(t + 2) * kstep; const char* b2 = last ? nB : cB + (size_t)(t + 2) * kstep;
            const char* a3 = a2 + kstep; const char* b3 = b2 + kstep;
            if (last && has_next) S.a_ready(nxt);
            if constexpr (SP2) {
            PG8_LDB(B0, 0, 0); PG8_LDB(B1, 0, 1); PG8_SCHED; PG8_LDA(At, 0, 0); PG8_STAGE(PG8_SA(1, 1), a1 + hstep, voffA);
            PG8_WAIT_V(8); PG8_WAIT_L(0); PG8_BAR; PG8_MMA(0, 0, At, B0); PG8_MMA(0, 1, At, B1); PG8_BAR; PG8_SCHED;
            PG8_LDA(At, 0, 1); PG8_STAGE(PG8_SB(0, 0), b2, voffB); PG8_STAGE(PG8_SB(0, 1), b2 + hstep, voffB); PG8_STAGE(PG8_SA(0, 0), a2, voffA);
            PG8_WAIT_V(8); PG8_WAIT_L(0); PG8_BAR; PG8_MMA(1, 0, At, B0); PG8_MMA(1, 1, At, B1); PG8_BAR; PG8_SCHED;
            PG8_LDB(B0, 1, 0); PG8_LDB(B1, 1, 1); PG8_SCHED; PG8_LDA(At, 1, 0); PG8_STAGE(PG8_SA(0, 1), a2 + hstep, voffA);
            PG8_WAIT_V(8); PG8_WAIT_L(0); PG8_BAR; PG8_MMA(0, 0, At, B0); PG8_MMA(0, 1, At, B1); PG8_BAR; PG8_SCHED;
            PG8_LDA(At, 1, 1); PG8_STAGE(PG8_SB(1, 0), b3, voffB); PG8_STAGE(PG8_SB(1, 1), b3 + hstep, voffB); PG8_STAGE(PG8_SA(1, 0), a3, voffA);
            PG8_WAIT_V(8); PG8_WAIT_L(0); PG8_BAR; PG8_MMA(1, 0, At, B0); PG8_MMA(1, 1, At, B1); PG8_BAR; PG8_SCHED;
            } else {
            PG8_LDB(B0, 0, 0); PG8_SCHED; PG8_LDA(At, 0, 0); PG8_STAGE(PG8_SA(1, 1), a1 + hstep, voffA);
            PG8_WAIT_L(8); PG8_BAR; PG8_WAIT_L(0); PG8_MMA(0, 0, At, B0); PG8_BAR; PG8_SCHED;
            PG8_LDB(B1, 0, 1); PG8_STAGE(PG8_SB(0, 0), b2, voffB);
            PG8_BAR; PG8_WAIT_L(0); PG8_MMA(0, 1, At, B1); PG8_BAR;
            PG8_LDA(At, 0, 1); PG8_STAGE(PG8_SA(0, 0), a2, voffA);
            PG8_BAR; PG8_WAIT_L(0); PG8_MMA(1, 0, At, B0); PG8_BAR; PG8_SCHED;
            PG8_STAGE(PG8_SB(0, 1), b2 + hstep, voffB);
            PG8_WAIT_V(6); PG8_BAR; PG8_MMA(1, 1, At, B1); PG8_BAR;
            PG8_LDB(B0, 1, 0); PG8_SCHED; PG8_LDA(At, 1, 0); PG8_STAGE(PG8_SA(0, 1), a2 + hstep, voffA);
            PG8_WAIT_L(8); PG8_BAR; PG8_WAIT_L(0); PG8_MMA(0, 0, At, B0); PG8_BAR; PG8_SCHED;
            PG8_LDB(B1, 1, 1); PG8_STAGE(PG8_SB(1, 0), b3, voffB);
            PG8_BAR; PG8_WAIT_L(0); PG8_MMA(0, 1, At, B1); PG8_BAR;
            PG8_LDA(At, 1, 1); PG8_STAGE(PG8_SA(1, 0), a3, voffA);
            PG8_BAR; PG8_WAIT_L(0); PG8_MMA(1, 0, At, B0); PG8_BAR; PG8_SCHED;
            PG8_STAGE(PG8_SB(1, 1), b3 + hstep, voffB);
            PG8_WAIT_V(6); PG8_BAR; PG8_MMA(1, 1, At, B1); PG8_BAR;
            }
        }
        if constexpr (ALIGN_EPI) { if (wr == 0) PG8_BAR; }
        if constexpr (!Epi::AFTER_DRAIN) { E(acc, cur, wr, wc, fr, fq); S.done(cur); }
        if (!has_next) break;
#pragma unroll
        for (int a = 0; a < 2; ++a)
#pragma unroll
            for (int b = 0; b < 2; ++b)
#pragma unroll
                for (int m = 0; m < 4; ++m)
#pragma unroll
                    for (int n = 0; n < 2; ++n) acc[a][b][m][n] = (acc_t){0, 0, 0, 0};
        cur = nxt; cA = nA; cB = nB; ++ui;
        if constexpr (ALIGN_EPI) { if (wr == 1) PG8_BAR; }
    }
    PG8_WAIT_V(0);
    if constexpr (!ALIGN_EPI) { if (wr == 0) PG8_BAR; }
    PG8_BAR;
#undef PG8_SA
#undef PG8_SB
#undef PG8_STAGE
#undef PG8_LDA
#undef PG8_LDB
#undef PG8_MMA
#undef PG8_WAIT_V
#undef PG8_WAIT_L
#undef PG8_BAR
#undef PG8_SCHED
}
}

constexpr int NWAVES = 8;
constexpr int D = 4096, M = 16384, NIN = 14336, DFF = 11008, NGU = 2 * DFF, PLE = 256, HD = 128, NH = 16;
constexpr int COL_RQ = 0, COL_RK = 2048, COL_RV = 4096, COL_RG = 6144, COL_AQ = 8192, COL_AK = 10240, COL_AV = 12288;
constexpr float RMS_EPS = 1e-6f, GN_EPS = 1e-5f;

constexpr size_t MiB = 1u << 20;
constexpr size_t WS_CTL = 0, CTL_ZERO_BYTES = 2 * MiB;
constexpr size_t WS_WIN = 2 * MiB;
constexpr size_t WS_WOUT = WS_WIN + (size_t)NIN * D * 2;
constexpr size_t WS_WGU = WS_WOUT + (size_t)D * D * 2;
constexpr size_t WS_WDN = WS_WGU + (size_t)NGU * D * 2;
constexpr size_t WS_WPG = WS_WDN + (size_t)D * DFF * 2;
constexpr size_t WS_WPP = WS_WPG + (size_t)D * D * 2;
constexpr size_t WS_PBF = WS_WPP + (size_t)D * PLE * 2;
constexpr size_t WS_U = WS_PBF + (size_t)M * PLE * 2;
constexpr size_t WS_MIX = WS_U + (size_t)M * D * 2;
constexpr size_t WS_PP = WS_MIX + (size_t)M * D * 2;
constexpr size_t WS_Z = WS_PP + (size_t)M * D * 2;
constexpr size_t WS_YF = WS_Z + (size_t)M * NIN * 2;
constexpr size_t WS_OP = WS_YF + (size_t)M * 2048 * 4;
constexpr size_t WS_LP = WS_OP + (size_t)3 * M * 2048 * 2;
constexpr size_t WS_XB2 = WS_LP + (size_t)3 * NH * M * 4;
constexpr size_t WS_EXP = WS_XB2 + (size_t)M * D * 2;
constexpr size_t WS_RA = WS_EXP + (size_t)64 * 65536;
constexpr size_t WS_DB = WS_RA + (size_t)M * 4;
constexpr size_t WS_DBP = WS_DB + (size_t)NGU * 4;
constexpr int NQI = 6144;
constexpr size_t WS_DBI = WS_DBP + (size_t)D * 4;
constexpr size_t WS_WINQ = WS_DBI + (size_t)NQI * 4;
constexpr size_t WS_END = WS_WINQ + (size_t)NQI * D;
constexpr size_t WS_XQ = WS_OP + (size_t)2 * M * 2048 * 2;
constexpr size_t WS_CMAX = 256 * 1024, WS_RMAX = 512 * 1024;
constexpr size_t WS_CMAXI = 512 * 1024;
constexpr size_t WS_RMAXG = 640 * 1024, WS_CMAXP = 768 * 1024;
static_assert(WS_CMAX + 2 * (size_t)NGU * 4 <= WS_RMAX && WS_RMAX + 2 * (size_t)M * 4 <= WS_RMAXG && WS_RMAXG + 2 * (size_t)M * 4 <= WS_CMAXP && WS_CMAXP + 2 * (size_t)D * 4 <= 1024 * 1024, "control region map");

constexpr int CW_BAR = 4096, CW_QUEUE = 2048, CW_FLAG = 8192;
constexpr size_t WS_SS = 1 * MiB;
static_assert(WS_SS + 7 * (size_t)M * 8 <= CTL_ZERO_BYTES, "SS inside the memset region");
constexpr int LDSCTL_OFF = 144384, MISC_OFF = LDSCTL_OFF + 320;
constexpr int LDS_BYTES = 147456;

#define GAS __attribute__((address_space(1)))
#define LAS __attribute__((address_space(3)))
typedef unsigned short bf16;
typedef unsigned v4u __attribute__((ext_vector_type(4)));
typedef unsigned v2u __attribute__((ext_vector_type(2)));
typedef float f32x4 __attribute__((ext_vector_type(4)));
typedef short bf16x8 __attribute__((ext_vector_type(8)));
#define LDS_WAIT() asm volatile("s_waitcnt lgkmcnt(0)" ::: "memory")
#define WG_BARRIER() do { asm volatile("s_waitcnt lgkmcnt(0)" ::: "memory"); __builtin_amdgcn_s_barrier(); asm volatile("" ::: "memory"); } while (0)
__device__ __forceinline__ unsigned pk2(float lo, float hi) { return pg8::cvt_pk_bf16(lo, hi); }
__device__ __forceinline__ float bf_lo(unsigned w) { return __uint_as_float(w << 16); }
__device__ __forceinline__ float bf_hi(unsigned w) { return __uint_as_float(w & 0xffff0000u); }
#define MFMA16(a, b, c) __builtin_amdgcn_mfma_f32_16x16x32_bf16((a), (b), (c), 0, 0, 0)

#define XB_TMO      128
#define XB_XCNT(j)  (256  + 64 * (j))
#define XB_XSUB(j)  (1280 + 64 * (j))
#define XB_XGEN(j)  (2304 + 64 * (j))
#define XB_TOP      3328
#define XB_TOPGEN   3392
#define XCD_BAR_WORDS 3456
#define XB_SPIN_CAP (1u << 18)

__device__ __forceinline__ unsigned xb_ld(unsigned* p)              { return __hip_atomic_load(p, __ATOMIC_RELAXED, __HIP_MEMORY_SCOPE_AGENT); }
__device__ __forceinline__ unsigned xb_add(unsigned* p, unsigned v) { return __hip_atomic_fetch_add(p, v, __ATOMIC_RELAXED, __HIP_MEMORY_SCOPE_AGENT); }
__device__ __forceinline__ unsigned xb_xcc_id() { return (unsigned)__builtin_amdgcn_s_getreg((3 << 11) | 20) & 0xFu; }
#define XB_SPIN(cond, bar) do { unsigned _sp = 0; while (cond) { __builtin_amdgcn_s_sleep(1); \
    if ((++_sp & 255u) == 0u) { if (xb_ld(&(bar)[XB_TMO])) break; if (_sp > XB_SPIN_CAP) { atomicAdd(&(bar)[XB_TMO], 1u); break; } } } } while (0)

struct XcdBarrier { unsigned* bar; unsigned x; volatile LAS unsigned* st; };

__device__ __forceinline__ XcdBarrier xcd_barrier_post(unsigned* bar, volatile LAS unsigned* st) {
    XcdBarrier b; b.bar = bar; b.x = xb_xcc_id(); b.st = st;
    if (threadIdx.x == 0) (void)xb_add(&bar[XB_XCNT(b.x)], 1u);
    return b;
}
__device__ __forceinline__ void xcd_barrier_complete(unsigned* bar, unsigned x, unsigned& nloc, unsigned& nx) {
    const unsigned G = gridDim.x * gridDim.y * gridDim.z;
    unsigned sum, cnt, mine, sp = 0u;
    for (;;) {
        sum = 0u; cnt = 0u; mine = 0u;
#pragma unroll
        for (unsigned j = 0; j < 16; ++j) { const unsigned c = xb_ld(&bar[XB_XCNT(j)]); sum += c; cnt += (c > 0u) ? 1u : 0u; mine = (j == x) ? c : mine; }
        if (sum == G) break;
        __builtin_amdgcn_s_sleep(1);
        if ((++sp & 255u) == 0u) { if (xb_ld(&bar[XB_TMO])) break; if (sp > XB_SPIN_CAP) { atomicAdd(&bar[XB_TMO], 1u); break; } }
    }
    nloc = mine > 0u ? mine : 1u; nx = cnt > 0u ? cnt : 1u;
}
__device__ __forceinline__ void xcd_barrier(const XcdBarrier& b) {
    asm volatile("s_waitcnt vmcnt(0)" ::: "memory");
    __syncthreads();
    if (threadIdx.x == 0) {
        unsigned* bar = b.bar;
        __builtin_amdgcn_s_waitcnt(0);
        unsigned nloc = b.st[0], nx = b.st[1];
        if (nloc == 0u) { xcd_barrier_complete(bar, b.x, nloc, nx); b.st[0] = nloc; b.st[1] = nx; }
        const unsigned old = xb_add(&bar[XB_XSUB(b.x)], 1u);
        const unsigned gen = old / nloc;
        if (old + 1u == (gen + 1u) * nloc) {
            __builtin_amdgcn_fence(__ATOMIC_RELEASE, "agent");
            asm volatile("s_waitcnt vmcnt(0)" ::: "memory");
            const unsigned og = xb_add(&bar[XB_TOP], 1u);
            const unsigned tg = og / nx;
            if (og + 1u == (tg + 1u) * nx) xb_add(&bar[XB_TOPGEN], 1u);
            else XB_SPIN(xb_ld(&bar[XB_TOPGEN]) == tg, bar);
            __builtin_amdgcn_fence(__ATOMIC_ACQUIRE, "agent");
            xb_add(&bar[XB_XGEN(b.x)], 1u);
            asm volatile("s_waitcnt vmcnt(0)" ::: "memory");
        } else {
            XB_SPIN(xb_ld(&bar[XB_XGEN(b.x)]) == gen, bar);
            __builtin_amdgcn_fence(__ATOMIC_ACQUIRE, "agent");
            asm volatile("s_waitcnt vmcnt(0)" ::: "memory");
        }
    }
    __syncthreads();
}

#define DPP_ROR(v, ctrl) __builtin_bit_cast(float, __builtin_amdgcn_update_dpp(0, __builtin_bit_cast(int, (v)), (ctrl), 0xf, 0xf, false))
__device__ __forceinline__ float row16_sum_f(float v) { v += DPP_ROR(v, 0x128); v += DPP_ROR(v, 0x124); v += DPP_ROR(v, 0x122); v += DPP_ROR(v, 0x121); return v; }
__device__ __forceinline__ float row16_max_f(float v) { v = fmaxf(v, DPP_ROR(v, 0x128)); v = fmaxf(v, DPP_ROR(v, 0x124)); v = fmaxf(v, DPP_ROR(v, 0x122)); v = fmaxf(v, DPP_ROR(v, 0x121)); return v; }
__device__ __forceinline__ float wave_sum(float v) {
#pragma unroll
    for (int o = 1; o < 64; o <<= 1) v += __shfl_xor(v, o);
    return v;
}
constexpr int TR_SCR = 64 * 65 * 4 + 256;
__device__ __forceinline__ void transpose_item(const float* W, int K, int N, bf16* WT, size_t trow0, int k0, int n0, float sc, const float* gk, LAS float* scr, int lane) {
    f32x4 v[16];
    { const float* src = W + (size_t)(k0 + (lane >> 4)) * N + n0 + 4 * (lane & 15);
#pragma unroll
      for (int i = 0; i < 16; ++i) v[i] = __builtin_nontemporal_load((const GAS f32x4*)(src + (size_t)(4 * i) * N)); }
    const int c = lane & 7;
    f32x4 ga = (f32x4){1.f, 1.f, 1.f, 1.f}, gb = ga;
    if (gk) { ga = *(const GAS f32x4*)(gk + k0 + 8 * c); gb = *(const GAS f32x4*)(gk + k0 + 8 * c + 4); }
    { LAS float* d = scr + (lane >> 4) * 65 + 4 * (lane & 15);
#pragma unroll
      for (int i = 0; i < 16; ++i) { d[(4 * i) * 65 + 0] = v[i].x; d[(4 * i) * 65 + 1] = v[i].y; d[(4 * i) * 65 + 2] = v[i].z; d[(4 * i) * 65 + 3] = v[i].w; } }
    LDS_WAIT(); asm volatile("" ::: "memory");
    float g8[8];
#pragma unroll
    for (int q = 0; q < 8; ++q) g8[q] = gk ? (q < 4 ? ga[q] : gb[q - 4]) * sc : sc;
#pragma unroll
    for (int j = 0; j < 8; ++j) { const int n = (lane >> 3) + 8 * j; const LAS float* s = scr + (8 * c) * 65 + n;
        v4u o; o.x = pk2(s[0 * 65] * g8[0], s[1 * 65] * g8[1]); o.y = pk2(s[2 * 65] * g8[2], s[3 * 65] * g8[3]); o.z = pk2(s[4 * 65] * g8[4], s[5 * 65] * g8[5]); o.w = pk2(s[6 * 65] * g8[6], s[7 * 65] * g8[7]);
        *(GAS v4u*)(WT + (trow0 + n) * (size_t)K + k0 + 8 * c) = o; }
    LDS_WAIT(); asm volatile("" ::: "memory");
}
__device__ __forceinline__ void colmax_item(const float* W, int N, const float* gk, int k0, int n0, unsigned* cmax, int lane) {
    const float* src = W + (size_t)(k0 + (lane >> 4)) * N + n0 + 4 * (lane & 15);
    f32x4 mx = (f32x4){0.f, 0.f, 0.f, 0.f};
#pragma unroll
    for (int i = 0; i < 16; ++i) { const f32x4 v = __builtin_nontemporal_load((const GAS f32x4*)(src + (size_t)(4 * i) * N)); const float g = gk[k0 + (lane >> 4) + 4 * i];
        mx.x = fmaxf(mx.x, fabsf(v.x * g)); mx.y = fmaxf(mx.y, fabsf(v.y * g)); mx.z = fmaxf(mx.z, fabsf(v.z * g)); mx.w = fmaxf(mx.w, fabsf(v.w * g)); }
#pragma unroll
    for (int o = 16; o < 64; o <<= 1) { mx.x = fmaxf(mx.x, __shfl_xor(mx.x, o)); mx.y = fmaxf(mx.y, __shfl_xor(mx.y, o)); mx.z = fmaxf(mx.z, __shfl_xor(mx.z, o)); mx.w = fmaxf(mx.w, __shfl_xor(mx.w, o)); }
    if (lane < 16) { unsigned* c = cmax + n0 + 4 * lane; atomicMax(c, __float_as_uint(mx.x)); atomicMax(c + 1, __float_as_uint(mx.y)); atomicMax(c + 2, __float_as_uint(mx.z)); atomicMax(c + 3, __float_as_uint(mx.w)); }
}
__device__ __forceinline__ void colmax_wide(const float* W, int N, const float* gk, int k0, int n0, unsigned* cmax, int lane) {
    const float* src = W + (size_t)k0 * N + n0 + 4 * lane;
    f32x4 mx = (f32x4){0.f, 0.f, 0.f, 0.f};
#pragma unroll
    for (int b = 0; b < 4; ++b) { f32x4 v[16];
#pragma unroll
        for (int i = 0; i < 16; ++i) v[i] = __builtin_nontemporal_load((const GAS f32x4*)(src + (size_t)(16 * b + i) * N));
#pragma unroll
        for (int i = 0; i < 16; ++i) { const float g = gk[k0 + 16 * b + i];
            mx.x = fmaxf(mx.x, fabsf(v[i].x * g)); mx.y = fmaxf(mx.y, fabsf(v[i].y * g)); mx.z = fmaxf(mx.z, fabsf(v[i].z * g)); mx.w = fmaxf(mx.w, fabsf(v[i].w * g)); } }
    unsigned* c = cmax + n0 + 4 * lane; atomicMax(c, __float_as_uint(mx.x)); atomicMax(c + 1, __float_as_uint(mx.y)); atomicMax(c + 2, __float_as_uint(mx.z)); atomicMax(c + 3, __float_as_uint(mx.w));
}
__device__ __forceinline__ void transpose_item_q(const float* W, int K, int N, signed char* WQ, size_t trow0, int k0, int n0, const float* gk, const unsigned* cmax, float* DB, LAS float* scr, int lane) {
    f32x4 v[16];
    const int c = lane & 7;
    { const float* src = W + (size_t)(k0 + (lane >> 4)) * N + n0 + 4 * (lane & 15);
#pragma unroll
      for (int i = 0; i < 16; ++i) v[i] = __builtin_nontemporal_load((const GAS f32x4*)(src + (size_t)(4 * i) * N)); }
    const f32x4 ga = *(const GAS f32x4*)(gk + k0 + 8 * c), gb = *(const GAS f32x4*)(gk + k0 + 8 * c + 4);
    float cmv[8];
#pragma unroll
    for (int j = 0; j < 8; ++j) cmv[j] = __uint_as_float(*(const GAS unsigned*)(cmax + n0 + (lane >> 3) + 8 * j));
    { LAS float* d = scr + (lane >> 4) * 65 + 4 * (lane & 15);
#pragma unroll
      for (int i = 0; i < 16; ++i) { d[(4 * i) * 65 + 0] = v[i].x; d[(4 * i) * 65 + 1] = v[i].y; d[(4 * i) * 65 + 2] = v[i].z; d[(4 * i) * 65 + 3] = v[i].w; } }
    LDS_WAIT(); asm volatile("" ::: "memory");
    const float g8[8] = {ga.x, ga.y, ga.z, ga.w, gb.x, gb.y, gb.z, gb.w};
#pragma unroll
    for (int j = 0; j < 8; ++j) { const int n = (lane >> 3) + 8 * j; const LAS float* s = scr + (8 * c) * 65 + n;
        const float cm = cmv[j]; const float inv = cm > 0.f ? 127.0f * __builtin_amdgcn_rcpf(cm) : 0.f;
        int q8[8];
#pragma unroll
        for (int q = 0; q < 8; ++q) q8[q] = (int)rintf(s[q * 65] * g8[q] * inv);
        v2u o; o.x = (unsigned)(q8[0] & 255) | ((unsigned)(q8[1] & 255) << 8) | ((unsigned)(q8[2] & 255) << 16) | ((unsigned)(q8[3] & 255) << 24);
        o.y = (unsigned)(q8[4] & 255) | ((unsigned)(q8[5] & 255) << 8) | ((unsigned)(q8[6] & 255) << 16) | ((unsigned)(q8[7] & 255) << 24);
        *(GAS v2u*)(WQ + (trow0 + n) * (size_t)K + k0 + 8 * c) = o;
        if (k0 == 0 && c == 0) DB[trow0 + n] = cm * (1.0f / 127.0f); }
    LDS_WAIT(); asm volatile("" ::: "memory");
}
struct QRow { v4u x[8]; };
__device__ __forceinline__ void quant_load(QRow& r, const bf16* xrow, int lane) {
    const GAS v4u* xr = (const GAS v4u*)xrow + lane;
#pragma unroll
    for (int j = 0; j < 8; ++j) r.x[j] = xr[64 * j];
}
__device__ __forceinline__ void quant_finish(const QRow& r, signed char* qrow, float* ra, int lane) {
    GAS v2u* qr = (GAS v2u*)qrow + lane;
    float rm = 0.f, ss = 0.f;
#pragma unroll
    for (int j = 0; j < 8; ++j)
#pragma unroll
        for (int q = 0; q < 4; ++q) { const float a = bf_lo(r.x[j][q]), b = bf_hi(r.x[j][q]); rm = fmaxf(rm, fmaxf(fabsf(a), fabsf(b))); ss += a * a + b * b; }
    rm = row16_max_f(rm); ss = row16_sum_f(ss);
    { const float r1 = __shfl_xor(rm, 16), s1 = __shfl_xor(ss, 16); rm = fmaxf(rm, r1); ss += s1; }
    { const float r1 = __shfl_xor(rm, 32), s1 = __shfl_xor(ss, 32); rm = fmaxf(rm, r1); ss += s1; }
    const float inv = rm > 0.f ? 127.0f * __builtin_amdgcn_rcpf(rm) : 0.f;
#pragma unroll
    for (int j = 0; j < 8; ++j) { int q8[8];
#pragma unroll
        for (int q = 0; q < 4; ++q) { q8[2 * q] = (int)rintf(bf_lo(r.x[j][q]) * inv); q8[2 * q + 1] = (int)rintf(bf_hi(r.x[j][q]) * inv); }
        v2u o; o.x = (unsigned)(q8[0] & 255) | ((unsigned)(q8[1] & 255) << 8) | ((unsigned)(q8[2] & 255) << 16) | ((unsigned)(q8[3] & 255) << 24);
        o.y = (unsigned)(q8[4] & 255) | ((unsigned)(q8[5] & 255) << 8) | ((unsigned)(q8[6] & 255) << 16) | ((unsigned)(q8[7] & 255) << 24);
        qr[64 * j] = o; }
    if (lane == 0) *ra = __builtin_amdgcn_rsqf(ss * (1.0f / 4096.0f) + 1e-6f) * rm * (1.0f / 127.0f);
}
__device__ __forceinline__ void quant_pass(const bf16* X, signed char* XQ, float* RA, int first, int step, int lane) {
    QRow A, B; int m = first;
    if (m < M) quant_load(A, X + (size_t)m * D, lane);
    _Pragma("nounroll") for (; m < M; m += 2 * step) {
        const int m1 = m + step, m2 = m + 2 * step;
        if (m1 < M) quant_load(B, X + (size_t)m1 * D, lane);
        quant_finish(A, XQ + (size_t)m * D, RA + m, lane);
        if (m2 < M) quant_load(A, X + (size_t)m2 * D, lane);
        if (m1 < M) quant_finish(B, XQ + (size_t)m1 * D, RA + m1, lane);
    }
}
constexpr int CV_IN = (D / 64) * (NIN / 64), CV_PP = (PLE / 64) * (D / 64), CV_A = CV_IN + CV_PP;
constexpr int CV_OUT = (D / 64) * (D / 64), CV_G = (D / 64) * (DFF / 64), CV_DN = (DFF / 64) * (D / 64), CV_ALL = CV_A + CV_OUT + 2 * CV_G + CV_DN + CV_OUT;
struct CvPtrs { const float *w_in, *w_pp, *w_out, *w_gate, *w_up, *w_down, *w_pg, *g_mix, *g_ffn, *g_ple; bf16 *WinT, *WppT, *WoutT, *WguT, *WdnT, *WpgT; const unsigned* cmax; float* DB; const unsigned* cmaxp; float* DBP; signed char* WinQ; const unsigned* cmaxi; float* DBI; };
__device__ __forceinline__ void convert_item(const CvPtrs& P, int it, LAS float* scr, int lane) {
    int r = it;
    if (r < CV_IN) { const int nblk = NIN / 64, kb = r / nblk, n0 = 64 * (r % nblk); const float sc = (n0 >= COL_RK && n0 < COL_RV) ? 0.08838834764831845f : 1.0f;
        const bool isv = n0 < COL_RK || (n0 >= COL_RV && n0 < COL_RG) || n0 >= COL_AV;
        if (isv) transpose_item_q(P.w_in, D, NIN, P.WinQ, (size_t)(n0 < COL_RK ? n0 : (n0 < COL_RG ? n0 - COL_RV + 2048 : n0 - COL_AV + 4096)), 64 * kb, n0, P.g_mix, P.cmaxi, P.DBI, scr, lane);
        else transpose_item(P.w_in, D, NIN, P.WinT, (size_t)(n0 < COL_RV ? n0 - COL_RK : n0 - 4096), 64 * kb, n0, sc, P.g_mix, scr, lane);
        return; } r -= CV_IN;
    if (r < CV_PP) { const int nblk = D / 64, kb = r / nblk, n0 = 64 * (r % nblk); transpose_item(P.w_pp, PLE, D, P.WppT, (size_t)n0, 64 * kb, n0, 1.0f, nullptr, scr, lane); return; } r -= CV_PP;
    if (r < CV_OUT) { const int nblk = D / 64, kb = r / nblk, n0 = 64 * (r % nblk); transpose_item(P.w_out, D, D, P.WoutT, (size_t)n0, 64 * kb, n0, 1.0f, nullptr, scr, lane); return; } r -= CV_OUT;
    if (r < CV_G) { const int nblk = DFF / 64, kb = r / nblk, n0 = 64 * (r % nblk); transpose_item_q(P.w_gate, D, DFF, (signed char*)P.WguT, (size_t)((n0 >> 7) * 256 + (n0 & 127)), 64 * kb, n0, P.g_ffn, P.cmax, P.DB, scr, lane); return; } r -= CV_G;
    if (r < CV_G) { const int nblk = DFF / 64, kb = r / nblk, n0 = 64 * (r % nblk); transpose_item_q(P.w_up, D, DFF, (signed char*)P.WguT, (size_t)((n0 >> 7) * 256 + 128 + (n0 & 127)), 64 * kb, n0, P.g_ffn, P.cmax + DFF, P.DB, scr, lane); return; } r -= CV_G;
    if (r < CV_DN) { const int nblk = D / 64, kb = r / nblk, n0 = 64 * (r % nblk); transpose_item(P.w_down, DFF, D, P.WdnT, (size_t)n0, 64 * kb, n0, 1.0f, nullptr, scr, lane); return; } r -= CV_DN;
    { const int nblk = D / 64, kb = r / nblk, n0 = 64 * (r % nblk); transpose_item_q(P.w_pg, D, D, (signed char*)P.WpgT, (size_t)n0, 64 * kb, n0, P.g_ple, P.cmaxp, P.DBP, scr, lane); }
}
#define CV_PTRS(P, ka, ws, layer) CvPtrs P; P.w_in = ka->in[5] + (size_t)(layer) * D * NIN; P.w_pp = ka->in[17] + (size_t)(layer) * PLE * D; P.w_out = ka->in[10] + (size_t)(layer) * D * D; \
    P.w_gate = ka->in[12] + (size_t)(layer) * D * DFF; P.w_up = ka->in[13] + (size_t)(layer) * D * DFF; P.w_down = ka->in[14] + (size_t)(layer) * DFF * D; P.w_pg = ka->in[16] + (size_t)(layer) * D * D; \
    P.g_mix = ka->in[4] + (size_t)(layer) * D; P.g_ffn = ka->in[11] + (size_t)(layer) * D; P.g_ple = ka->in[15] + (size_t)(layer) * D; \
    P.WinT = (bf16*)(ws + WS_WIN); P.WppT = (bf16*)(ws + WS_WPP); P.WoutT = (bf16*)(ws + WS_WOUT); P.WguT = (bf16*)(ws + WS_WGU); P.WdnT = (bf16*)(ws + WS_WDN); P.WpgT = (bf16*)(ws + WS_WPG); \
    P.cmax = (const unsigned*)(ws + WS_CMAX) + (size_t)(layer) * NGU; P.DB = (float*)(ws + WS_DB); P.cmaxp = (const unsigned*)(ws + WS_CMAXP) + (size_t)(layer) * D; P.DBP = (float*)(ws + WS_DBP); \
    P.WinQ = (signed char*)(ws + WS_WINQ); P.cmaxi = (const unsigned*)(ws + WS_CMAXI) + (size_t)(layer) * NIN; P.DBI = (float*)(ws + WS_DBI)

__device__ __forceinline__ void x_row_in(const float* xrow, bf16* orow, pg8::u64_t* ss, signed char* qrow, float* ra, int lane) {
    const GAS f32x4* xr = (const GAS f32x4*)xrow + lane;
    f32x4 v[16];
#pragma unroll
    for (int j = 0; j < 16; ++j) v[j] = __builtin_nontemporal_load(xr + 64 * j);
    GAS v2u* o8 = (GAS v2u*)orow + lane; float s = 0.f, mx = 0.f;
#pragma unroll
    for (int j = 0; j < 16; ++j) { v2u o; o.x = pk2(v[j].x, v[j].y); o.y = pk2(v[j].z, v[j].w); o8[64 * j] = o;
        const float a = bf_lo(o.x), b = bf_hi(o.x), c = bf_lo(o.y), d = bf_hi(o.y); s += (a * a + b * b) + (c * c + d * d); v[j] = (f32x4){a, b, c, d};
        mx = fmaxf(mx, fmaxf(fmaxf(fabsf(a), fabsf(b)), fmaxf(fabsf(c), fabsf(d)))); }
    s = row16_sum_f(s); mx = row16_max_f(mx);
    { const float m1 = __shfl_xor(mx, 16), s1 = __shfl_xor(s, 16); mx = fmaxf(mx, m1); s += s1; }
    { const float m1 = __shfl_xor(mx, 32), s1 = __shfl_xor(s, 32); mx = fmaxf(mx, m1); s += s1; }
    const pg8::u64_t sf = pg8::ss_fix(s); const float inv = mx > 0.f ? 127.0f * __builtin_amdgcn_rcpf(mx) : 0.f;
    GAS unsigned* q4 = (GAS unsigned*)qrow + lane;
#pragma unroll
    for (int j = 0; j < 16; ++j) { const int q0 = (int)rintf(v[j].x * inv), q1 = (int)rintf(v[j].y * inv), q2 = (int)rintf(v[j].z * inv), q3 = (int)rintf(v[j].w * inv);
        q4[64 * j] = (unsigned)(q0 & 255) | ((unsigned)(q1 & 255) << 8) | ((unsigned)(q2 & 255) << 16) | ((unsigned)(q3 & 255) << 24); }
    if (lane == 0) { *ss = sf; *ra = pg8::ss_rs(sf) * mx * (1.0f / 127.0f); }
}

__device__ __forceinline__ float fast_rsqrt(float x) { return __builtin_amdgcn_rsqf(x); }
__device__ __forceinline__ float row16_sum(float v) {
    v += __builtin_bit_cast(float, __builtin_amdgcn_update_dpp(0, __builtin_bit_cast(int, v), 0x128, 0xf, 0xf, false));
    v += __builtin_bit_cast(float, __builtin_amdgcn_update_dpp(0, __builtin_bit_cast(int, v), 0x124, 0xf, 0xf, false));
    v += __builtin_bit_cast(float, __builtin_amdgcn_update_dpp(0, __builtin_bit_cast(int, v), 0x122, 0xf, 0xf, false));
    v += __builtin_bit_cast(float, __builtin_amdgcn_update_dpp(0, __builtin_bit_cast(int, v), 0x121, 0xf, 0xf, false));
    return v;
}
constexpr int RS = 272;
constexpr int RSB = 288;
constexpr int R_K = 0, R_KW = 128 * RS, R_V = R_KW + 128 * RSB, R_ST = R_V + 128 * RSB;
constexpr int R_GN = R_ST + 128 * RS;
static_assert(R_GN + 512 <= LDSCTL_OFF, "retention LDS");
typedef short s16x4 __attribute__((ext_vector_type(4)));
__device__ __forceinline__ s16x4 ds_tr(LAS unsigned char* p) { return __builtin_bit_cast(s16x4, __builtin_amdgcn_ds_read_tr16_b64_v4i16((LAS s16x4*)p)); }
__device__ __forceinline__ bf16x8 ds_tr2(LAS unsigned char* p, int rstride) { const s16x4 a = ds_tr(p), b = ds_tr(p + 16 * rstride); bf16x8 r; r[0] = a[0]; r[1] = a[1]; r[2] = a[2]; r[3] = a[3]; r[4] = b[0]; r[5] = b[1]; r[6] = b[2]; r[7] = b[3]; return r; }
__device__ __forceinline__ v4u scale8(v4u x, float sc) { v4u o; o.x = pk2(bf_lo(x.x) * sc, bf_hi(x.x) * sc); o.y = pk2(bf_lo(x.y) * sc, bf_hi(x.y) * sc); o.z = pk2(bf_lo(x.z) * sc, bf_hi(x.z) * sc); o.w = pk2(bf_lo(x.w) * sc, bf_hi(x.w) * sc); return o; }

__device__ __forceinline__ void seq_info(int seq, int& rowbase, int& L) { if (seq < 2) { rowbase = seq * 4096; L = 4096; } else { rowbase = 8192 + (seq - 2) * 2048; L = 2048; } }
__device__ __forceinline__ const bf16* zplane(const bf16* ZH, int sec, int h) { return ZH + (size_t)(sec * NH + h) * M * HD; }

#define RLX_AGENT __ATOMIC_RELAXED, __HIP_MEMORY_SCOPE_AGENT
template <int DIR, bool INTRA, bool FINAL> __device__ __forceinline__ void retention_pass(LAS unsigned char* lds, const bf16* ZH, bf16* YF, bf16* MIX, const float* ld, const float* gn, int seq, int h, int n0, int ncnt,
                                                                                          const unsigned long long* imp, unsigned* impflag, unsigned long long* expo, unsigned* expflag, int tid0) {
    int rowbase, L; seq_info(seq, rowbase, L);
    const bf16* Qp = zplane(ZH, 0, h) + (size_t)rowbase * HD; const bf16* Kp = zplane(ZH, 1, h) + (size_t)rowbase * HD;
    const bf16* Vp = zplane(ZH, 2, h) + (size_t)rowbase * HD; const bf16* Gp = zplane(ZH, 3, h) + (size_t)rowbase * HD;
    const float lf0 = ld[h], lb0 = ld[NH + h];
    f32x4 st[8];
    {
        const float gC = __expf((DIR == 0 ? lf0 : lb0) * 128.f);
        v4u kreg[4], vreg[4]; bf16x8 qf[4];
        { const int n = DIR == 0 ? n0 : n0 + ncnt - 1; const int srow = tid0 >> 4, sch = tid0 & 15, w = tid0 >> 6, lr = tid0 & 15, lg = (tid0 >> 4) & 3;
#pragma unroll
          for (int cc = 0; cc < 4; ++cc) { kreg[cc] = *(const GAS v4u*)(Kp + (size_t)(n * 128 + srow + 32 * cc) * HD + 8 * sch); vreg[cc] = *(const GAS v4u*)(Vp + (size_t)(n * 128 + srow + 32 * cc) * HD + 8 * sch); }
#pragma unroll
          for (int ks = 0; ks < 4; ++ks) qf[ks] = *(const GAS bf16x8*)(Qp + (size_t)(n * 128 + 16 * w + lr) * HD + 8 * lg + 32 * ks); }
        if (imp) {
            if (tid0 == 0) { unsigned spins = 0; while (__hip_atomic_load(impflag, RLX_AGENT) == 0u && ++spins < (1u << 22)) __builtin_amdgcn_s_sleep(2); }
            __syncthreads();
#pragma unroll
            for (int e = 0; e < 8; ++e) { const unsigned long long a = __hip_atomic_load(imp + (size_t)(e * 512 + tid0) * 2, RLX_AGENT), b = __hip_atomic_load(imp + (size_t)(e * 512 + tid0) * 2 + 1, RLX_AGENT);
                st[e][0] = __uint_as_float((unsigned)a); st[e][1] = __uint_as_float((unsigned)(a >> 32)); st[e][2] = __uint_as_float((unsigned)b); st[e][3] = __uint_as_float((unsigned)(b >> 32)); }
        } else {
#pragma unroll
            for (int e = 0; e < 8; ++e) st[e] = (f32x4){0.f, 0.f, 0.f, 0.f};
        }
        if constexpr (FINAL) {
            if (tid0 < 32) *(LAS f32x4*)(lds + R_GN + 16 * tid0) = *(const GAS f32x4*)(gn + h * HD + 4 * tid0);
        }
        for (int cn = 0; cn < ncnt; ++cn) {
            const int n = DIR == 0 ? n0 + cn : n0 + ncnt - 1 - cn, nn = DIR == 0 ? n + 1 : n - 1;
            const int r0 = rowbase + n * 128;
            int tid = tid0; float lf = lf0, lb = lb0; asm volatile("" : "+v"(tid), "+v"(lf), "+v"(lb));
            const int w = tid >> 6, l = tid & 63, lr = l & 15, lg = l >> 4, srow = tid >> 4, sch = tid & 15;
            LAS unsigned char* trp = lds + (4 * lg + ((l & 15) >> 2)) * RSB + (l & 3) * 8;
            WG_BARRIER();
#pragma unroll
            for (int cc = 0; cc < 4; ++cc) { const int row = srow + 32 * cc;
                if constexpr (INTRA) *(LAS v4u*)(lds + R_K + row * RS + 16 * sch) = kreg[cc];
                const float wj = DIR == 0 ? __expf(lf * (float)(127 - row)) : __expf(lb * (float)row);
                *(LAS v4u*)(lds + R_KW + row * RSB + 16 * sch) = scale8(kreg[cc], wj);
                *(LAS v4u*)(lds + R_V + row * RSB + 16 * sch) = vreg[cc]; }
#pragma unroll
            for (int e = 0; e < 8; ++e) { v2u o; o.x = pk2(st[e][0], st[e][1]); o.y = pk2(st[e][2], st[e][3]); *(LAS v2u*)(lds + R_ST + (16 * e + lr) * RS + (16 * w + 4 * lg) * 2) = o; }
            WG_BARRIER();
            bf16x8 qx[4];
            { const float xi = DIR == 0 ? __expf(lf * (float)(16 * w + lr + 1)) : __expf(lb * (float)(128 - 16 * w - lr));
#pragma unroll
              for (int ks = 0; ks < 4; ++ks) qx[ks] = __builtin_bit_cast(bf16x8, scale8(__builtin_bit_cast(v4u, qf[ks]), xi)); }
            bf16x8 pt[4];
            if constexpr (INTRA) {
                f32x4 s[8];
#pragma unroll
                for (int jt = 0; jt < 8; ++jt) { s[jt] = (f32x4){0.f, 0.f, 0.f, 0.f};
#pragma unroll
                    for (int ks = 0; ks < 4; ++ks) { const bf16x8 a = *(const LAS bf16x8*)(lds + R_K + (16 * jt + lr) * RS + (8 * lg + 32 * ks) * 2); s[jt] = MFMA16(a, qf[ks], s[jt]); }
                    __builtin_amdgcn_sched_barrier(0); }
                float Fr[4], Br[4];
#pragma unroll
                for (int r = 0; r < 4; ++r) { const float br = (float)(lr - 4 * lg - r); Fr[r] = __expf(lf * br); Br[r] = __expf(-lb * br); }
#pragma unroll
                for (int jt = 0; jt < 8; ++jt) { const int dt = w - jt; const float cf = __expf(lf * 16.f * (float)dt), cb = __expf(-lb * 16.f * (float)dt);
#pragma unroll
                    for (int r = 0; r < 4; ++r) { const float dec = dt > 0 ? Fr[r] * cf : (dt < 0 ? Br[r] * cb : ((lr - 4 * lg - r) >= 0 ? Fr[r] : Br[r])); s[jt][r] *= dec; } }
#pragma unroll
                for (int ks = 0; ks < 4; ++ks) { v4u o; o.x = pk2(s[2 * ks][0], s[2 * ks][1]); o.y = pk2(s[2 * ks][2], s[2 * ks][3]); o.z = pk2(s[2 * ks + 1][0], s[2 * ks + 1][1]); o.w = pk2(s[2 * ks + 1][2], s[2 * ks + 1][3]); pt[ks] = __builtin_bit_cast(bf16x8, o); }
            }
            f32x4 y[8];
#pragma unroll
            for (int e = 0; e < 8; ++e) y[e] = (f32x4){0.f, 0.f, 0.f, 0.f};
            { bf16x8 kwf[4];
#pragma unroll
              for (int ks = 0; ks < 4; ++ks) kwf[ks] = ds_tr2(trp + R_KW + (32 * ks) * RSB + (16 * w) * 2, RSB);
#pragma unroll
              for (int e = 0; e < 8; ++e) { st[e] = st[e] * gC;
#pragma unroll
                for (int ks = 0; ks < 4; ++ks) { const bf16x8 vf = ds_tr2(trp + R_V + (32 * ks) * RSB + (16 * e) * 2, RSB);
                    if constexpr (INTRA) y[e] = MFMA16(vf, pt[ks], y[e]);
                    st[e] = MFMA16(kwf[ks], vf, st[e]); }
                __builtin_amdgcn_sched_barrier(0); } }
            v2u ywv[8], gwv[8];
            if constexpr (FINAL) { const int row_ = r0 + 16 * w + lr; const bf16* yp_ = YF + (size_t)row_ * 2048 + h * HD + 4 * lg; const bf16* gp_ = Gp + (size_t)(n * 128 + 16 * w + lr) * HD + 4 * lg;
#pragma unroll
                for (int e = 0; e < 8; ++e) { ywv[e] = *(const GAS v2u*)(yp_ + 16 * e); gwv[e] = *(const GAS v2u*)(gp_ + 16 * e); } }
            if (cn + 1 < ncnt) {
#pragma unroll
              for (int cc = 0; cc < 4; ++cc) { kreg[cc] = *(const GAS v4u*)(Kp + (size_t)(nn * 128 + srow + 32 * cc) * HD + 8 * sch); vreg[cc] = *(const GAS v4u*)(Vp + (size_t)(nn * 128 + srow + 32 * cc) * HD + 8 * sch); }
#pragma unroll
              for (int ks = 0; ks < 4; ++ks) qf[ks] = *(const GAS bf16x8*)(Qp + (size_t)(nn * 128 + 16 * w + lr) * HD + 8 * lg + 32 * ks); }
#pragma unroll
            for (int e = 0; e < 8; ++e) {
#pragma unroll
                for (int ks = 0; ks < 4; ++ks) { const bf16x8 sf = *(const LAS bf16x8*)(lds + R_ST + (16 * e + lr) * RS + (8 * lg + 32 * ks) * 2); y[e] = MFMA16(sf, qx[ks], y[e]); }
                __builtin_amdgcn_sched_barrier(0); }
            const int row = r0 + 16 * w + lr;
            bf16* yp = YF + (size_t)row * 2048 + h * HD + 4 * lg;
            if constexpr (!FINAL) {
#pragma unroll
                for (int e = 0; e < 8; ++e) { v2u o; o.x = pk2(y[e][0], y[e][1]); o.y = pk2(y[e][2], y[e][3]); *(GAS v2u*)(yp + 16 * e) = o; }
            } else {
                float sum = 0.f;
#pragma unroll
                for (int e = 0; e < 8; ++e) { const v2u yw = ywv[e]; y[e][0] += bf_lo(yw.x); y[e][1] += bf_hi(yw.x); y[e][2] += bf_lo(yw.y); y[e][3] += bf_hi(yw.y); sum += (y[e][0] + y[e][1]) + (y[e][2] + y[e][3]); }
                sum += __shfl_xor(sum, 16); sum += __shfl_xor(sum, 32);
                const float mu = sum * (1.f / 128.f); float q = 0.f;
#pragma unroll
                for (int e = 0; e < 8; ++e) { y[e] = y[e] - mu; q += (y[e][0] * y[e][0] + y[e][1] * y[e][1]) + (y[e][2] * y[e][2] + y[e][3] * y[e][3]); }
                q += __shfl_xor(q, 16); q += __shfl_xor(q, 32);
                const float rstd = fast_rsqrt(q * (1.f / 128.f) + GN_EPS);
                bf16* mp = MIX + (size_t)row * D + h * HD + 4 * lg;
#pragma unroll
                for (int e = 0; e < 8; ++e) { const v2u gw2 = gwv[e]; const f32x4 gg = *(const LAS f32x4*)(lds + R_GN + (16 * e + 4 * lg) * 4);
                    const float g0 = bf_lo(gw2.x), g1 = bf_hi(gw2.x), g2 = bf_lo(gw2.y), g3 = bf_hi(gw2.y);
                    v2u o; o.x = pk2(g0 * pg8::fast_sigmoid(g0) * (y[e][0] * rstd * gg.x), g1 * pg8::fast_sigmoid(g1) * (y[e][1] * rstd * gg.y));
                    o.y = pk2(g2 * pg8::fast_sigmoid(g2) * (y[e][2] * rstd * gg.z), g3 * pg8::fast_sigmoid(g3) * (y[e][3] * rstd * gg.w));
                    *(GAS v2u*)(mp + 16 * e) = o; }
            }
        }
        if (expo) {
#pragma unroll
            for (int e = 0; e < 8; ++e) { __hip_atomic_store(expo + (size_t)(e * 512 + tid0) * 2, (unsigned long long)__float_as_uint(st[e][0]) | ((unsigned long long)__float_as_uint(st[e][1]) << 32), RLX_AGENT);
                __hip_atomic_store(expo + (size_t)(e * 512 + tid0) * 2 + 1, (unsigned long long)__float_as_uint(st[e][2]) | ((unsigned long long)__float_as_uint(st[e][3]) << 32), RLX_AGENT); }
            asm volatile("s_waitcnt vmcnt(0)" ::: "memory");
            __syncthreads();
            if (tid0 == 0) __hip_atomic_store(expflag, 1u, RLX_AGENT);
        }
        __syncthreads();
    }
}

__device__ __forceinline__ void retention_item(LAS unsigned char* lds, const bf16* ZH, bf16* YF, bf16* MIX, const float* ld, const float* gn, unsigned long long* EXP, unsigned* flags, int item, int tid0) {
    if (item < 64) {
        const int chain = item & 31, seq = chain >> 4, h = chain & 15;
        unsigned long long* slot_f = EXP + (size_t)(chain * 2 + 0) * 8192; unsigned long long* slot_b = EXP + (size_t)(chain * 2 + 1) * 8192;
        unsigned* flag_f = flags + 64 * (chain * 2 + 0); unsigned* flag_b = flags + 64 * (chain * 2 + 1);
        if (item < 32) { retention_pass<0, true, false>(lds, ZH, YF, MIX, ld, gn, seq, h, 0, 16, nullptr, nullptr, slot_f, flag_f, tid0);
                         retention_pass<1, false, true>(lds, ZH, YF, MIX, ld, gn, seq, h, 0, 16, slot_b, flag_b, nullptr, nullptr, tid0); }
        else           { retention_pass<1, false, false>(lds, ZH, YF, MIX, ld, gn, seq, h, 16, 16, nullptr, nullptr, slot_b, flag_b, tid0);
                         retention_pass<0, true, true>(lds, ZH, YF, MIX, ld, gn, seq, h, 16, 16, slot_f, flag_f, nullptr, nullptr, tid0); }
    } else {
        const int c = item - 64, seq = 2 + (c >> 4), h = c & 15;
        retention_pass<0, true, false>(lds, ZH, YF, MIX, ld, gn, seq, h, 0, 16, nullptr, nullptr, nullptr, nullptr, tid0);
        retention_pass<1, false, true>(lds, ZH, YF, MIX, ld, gn, seq, h, 0, 16, nullptr, nullptr, nullptr, nullptr, tid0);
    }
}

constexpr int A_K = 0, A_V = 256 * RS;
static_assert(A_V + 256 * RSB <= LDSCTL_OFF, "attention LDS");
struct AttBlk { int d, dsh, r, qi0, m, b; };
__device__ __forceinline__ AttBlk att_blk(int blk, int t0, int L) {
    AttBlk a;
    if (blk < 16) { a.dsh = 4; a.r = blk; a.b = 0; } else if (blk < 32) { a.dsh = 2; a.r = (blk - 16) >> 2; a.b = (blk - 16) & 3; } else { a.dsh = 0; a.r = 0; a.b = blk - 32; }
    a.d = 1 << a.dsh; a.m = L >> a.dsh; a.qi0 = (t0 >> a.dsh) + 128 * a.b; return a;
}
__device__ __forceinline__ void attention_item(LAS unsigned char* lds, const bf16* ZH, bf16* OP, float* LP, bf16* MIX, const float* qg, const float* kg, int item, int tid0) {
    const int s8 = item >> 4, h = item & 15;
    int seq, t0; if (s8 < 4) { seq = s8 >> 1; t0 = (s8 & 1) * 2048; } else { seq = s8 - 2; t0 = 0; }
    int rowbase, L; seq_info(seq, rowbase, L);
    const float slope = exp2f(-0.5f * (float)(h + 1));
    float smax;
    { const int l = tid0 & 63; float mq = fmaxf(fabsf(qg[l]), fabsf(qg[l + 64])), mk = fmaxf(fabsf(kg[l]), fabsf(kg[l + 64]));
#pragma unroll
      for (int o = 1; o < 64; o <<= 1) { mq = fmaxf(mq, __shfl_xor(mq, o)); mk = fmaxf(mk, __shfl_xor(mk, o)); }
      smax = mq * mk * 11.3137085f; }
    const bf16* Qp = zplane(ZH, 4, h) + (size_t)rowbase * HD; const bf16* Kp = zplane(ZH, 5, h) + (size_t)rowbase * HD; const bf16* Vp = zplane(ZH, 6, h) + (size_t)rowbase * HD;
    auto att_load = [&](v4u (&kq)[8], v4u (&vq)[8], int BLK) __attribute__((always_inline)) {
        const AttBlk nb_ = att_blk(BLK, t0, L); const int krow_ = tid0 >> 4, kc_ = tid0 & 15;
#pragma unroll
        for (int p = 0; p < 8; ++p) if (p >= 4 || nb_.b == 0) { const int kidx = nb_.qi0 - 64 + 32 * p + krow_; kq[p] = (v4u){0u, 0u, 0u, 0u}; vq[p] = (v4u){0u, 0u, 0u, 0u};
            if ((unsigned)kidx < (unsigned)nb_.m) { const unsigned ro = (unsigned)((nb_.r + nb_.d * kidx) * HD + 8 * kc_) * 2u; kq[p] = *(const GAS v4u*)((const GAS char*)Kp + ro); vq[p] = *(const GAS v4u*)((const GAS char*)Vp + ro); } }
    };
    auto att_load_q = [&](v4u (&qw)[4], int BLK) __attribute__((always_inline)) {
        const AttBlk nb_ = att_blk(BLK, t0, L); const int w_ = tid0 >> 6, lr_ = tid0 & 15, lg_ = (tid0 >> 4) & 3;
        const unsigned qo_ = (unsigned)((nb_.r + nb_.d * (nb_.qi0 + 16 * w_ + lr_)) * HD + 8 * lg_) * 2u;
#pragma unroll
        for (int ks = 0; ks < 4; ++ks) qw[ks] = *(const GAS v4u*)((const GAS char*)Qp + qo_ + 64 * ks);
    };
    auto att_body = [&](v4u (&kq)[8], v4u (&vq)[8], v4u (&qw)[4], int blk) __attribute__((always_inline)) {
        const AttBlk B = att_blk(blk, t0, L);
        if (blk == 32) __syncthreads();
        int tid = tid0; asm volatile("" : "+v"(tid));
        const int w = tid >> 6, l = tid & 63, lr = l & 15, lg = l >> 4, krow = tid >> 4, kc = tid & 15, jt0 = w & ~1;
        const int off = 128 * (B.b & 1);
        const float sd = slope * (float)B.d;
        bf16x8 qf[4];
#pragma unroll
        for (int ks = 0; ks < 4; ++ks) qf[ks] = __builtin_bit_cast(bf16x8, qw[ks]);
        WG_BARRIER();
#pragma unroll
        for (int p = 0; p < 8; ++p) if (p >= 4 || B.b == 0) { const int slot = (32 * p + krow + off) & 255;
            *(LAS v4u*)(lds + A_K + slot * RS + 16 * kc) = kq[p];
            *(LAS v4u*)(lds + A_V + slot * RSB + 16 * kc) = vq[p]; }
        WG_BARRIER();
        f32x4 sT[10];
#pragma unroll
        for (int t = 0; t < 10; ++t) sT[t] = (f32x4){0.f, 0.f, 0.f, 0.f};
#pragma unroll
        for (int ks = 0; ks < 4; ++ks) {
#pragma unroll
            for (int t = 0; t < 10; ++t) { const int rowb = (16 * (jt0 + t) + off) & 255;
                const bf16x8 a = *(const LAS bf16x8*)(lds + A_K + (rowb + lr) * RS + (8 * lg + 32 * ks) * 2); sT[t] = MFMA16(a, qf[ks], sT[t]);
                if (t == 4) __builtin_amdgcn_sched_barrier(0); }
            __builtin_amdgcn_sched_barrier(0); }
        if (blk + 1 < 48) att_load_q(qw, blk + 1);
        float lsum = 0.f;
        {
          const int i = 16 * w + lr, rb = 16 * jt0 + 4 * lg - 64 - i, lo_i = -(i + B.qi0), hi_i = B.m - 1 - i - B.qi0;
          const float rbf = (float)rb, LO = (float)(lo_i > -64 ? lo_i : -64), HI = (float)(hi_i < 64 ? hi_i : 64);
          const float L2E = 1.4426950408889634f, sdl = sd * L2E, sml = smax * L2E;
#pragma unroll
          for (int t = 0; t < 10; ++t)
#pragma unroll
            for (int rr = 0; rr < 4; ++rr) { const float relf = rbf + (float)(16 * t + rr);
                const float x = __builtin_fmaf(sT[t][rr], L2E, __builtin_fmaf(-sdl, __builtin_fabsf(relf), -sml));
                const bool ok = __builtin_amdgcn_fmed3f(relf, LO, HI) == relf;
                const float p = ok ? __builtin_amdgcn_exp2f(x) : 0.f; sT[t][rr] = p; lsum += p; } }
        bf16x8 pt[5];
#pragma unroll
        for (int k = 0; k < 5; ++k) { v4u o; o.x = pk2(sT[2 * k][0], sT[2 * k][1]); o.y = pk2(sT[2 * k][2], sT[2 * k][3]); o.z = pk2(sT[2 * k + 1][0], sT[2 * k + 1][1]); o.w = pk2(sT[2 * k + 1][2], sT[2 * k + 1][3]); pt[k] = __builtin_bit_cast(bf16x8, o); }
        f32x4 o[8];
        { LAS unsigned char* trp = lds + A_V + (4 * lg + ((l & 15) >> 2)) * RSB + (l & 3) * 8;
#pragma unroll
          for (int e = 0; e < 8; ++e) o[e] = (f32x4){0.f, 0.f, 0.f, 0.f};
#pragma unroll
          for (int k = 0; k < 5; ++k) { const int rowb = (16 * jt0 + 32 * k + off) & 255;
#pragma unroll
            for (int e = 0; e < 8; ++e) { const bf16x8 vf = ds_tr2(trp + rowb * RSB + (16 * e) * 2, RSB); o[e] = MFMA16(vf, pt[k], o[e]);
                if (e == 3) __builtin_amdgcn_sched_barrier(0); }
            __builtin_amdgcn_sched_barrier(0); } }
        lsum += __shfl_xor(lsum, 16); lsum += __shfl_xor(lsum, 32);
        const int row = rowbase + B.r + B.d * (B.qi0 + 16 * w + lr);
        if (B.dsh != 0) {
            const int pb = B.dsh == 4 ? 0 : 1;
            bf16* op = OP + ((size_t)pb * M + row) * 2048 + h * HD + 4 * lg;
#pragma unroll
            for (int e = 0; e < 8; ++e) { v2u ov; ov.x = pk2(o[e][0], o[e][1]); ov.y = pk2(o[e][2], o[e][3]); *(GAS v2u*)(op + 16 * e) = ov; }
            if (lg == 0) LP[((size_t)pb * NH + h) * M + row] = lsum;
        } else {
            const bf16* p0 = OP + ((size_t)0 * M + row) * 2048 + h * HD + 4 * lg; const bf16* p1 = OP + ((size_t)1 * M + row) * 2048 + h * HD + 4 * lg;
            v2u pa[8], pc[8];
#pragma unroll
            for (int e = 0; e < 8; ++e) { pa[e] = *(const GAS v2u*)(p0 + 16 * e); pc[e] = *(const GAS v2u*)(p1 + 16 * e); }
            const float inv = __builtin_amdgcn_rcpf(lsum + LP[((size_t)0 * NH + h) * M + row] + LP[((size_t)1 * NH + h) * M + row]);
            bf16* mp = MIX + (size_t)row * D + 2048 + h * HD + 4 * lg;
#pragma unroll
            for (int e = 0; e < 8; ++e) { const v2u a = pa[e], c = pc[e];
                v2u ov; ov.x = pk2((o[e][0] + bf_lo(a.x) + bf_lo(c.x)) * inv, (o[e][1] + bf_hi(a.x) + bf_hi(c.x)) * inv); ov.y = pk2((o[e][2] + bf_lo(a.y) + bf_lo(c.y)) * inv, (o[e][3] + bf_hi(a.y) + bf_hi(c.y)) * inv);
                *(GAS v2u*)(mp + 16 * e) = ov; }
        }
    };
    v4u kA[8], vA[8], kB[8], vB[8], qW[4];
    att_load(kA, vA, 0); att_load_q(qW, 0);
    _Pragma("nounroll") for (int blk = 0; blk < 48; blk += 2) {
        att_load(kB, vB, blk + 1);
        att_body(kA, vA, qW, blk);
        if (blk + 2 < 48) att_load(kA, vA, blk + 2);
        att_body(kB, vB, qW, blk + 1);
    }
    __syncthreads();
}

#ifndef PHMASK
#define PHMASK 0x3FF
#endif
#ifndef NLAYER
#define NLAYER 2
#endif
#ifndef DUPMASK
#define DUPMASK 0
#endif
struct Args { const float* in[18]; float* out; unsigned char* ws; };
typedef __attribute__((address_space(4))) const Args CArgs;
__device__ __forceinline__ CArgs* kargs() { CArgs* p = (CArgs*)__builtin_amdgcn_kernarg_segment_ptr(); asm volatile("" : "+s"(p)); return p; }
#define PHASE_PROLOG() CArgs* ka = kargs(); unsigned char* ws = ka->ws; (void)ws; const int tid = opaque_tid(), lane = tid & 63, wave = __builtin_amdgcn_readfirstlane(tid >> 6), gw = vcu * NWAVES + wave; (void)lane; (void)gw
__global__ void __launch_bounds__(NWAVES * 64, 2) fwd_kernel(Args args_unused) {
    extern __shared__ __attribute__((aligned(16))) unsigned char lds_raw[];
    LAS unsigned char* lds = (LAS unsigned char*)lds_raw;
    volatile LAS unsigned* MISC = (volatile LAS unsigned*)(lds + MISC_OFF);
#define G ((int)gridDim.x)
#define bx ((int)blockIdx.x)
#define vcu ((G % 8 == 0) ? (bx % 8) * (G / 8) + bx / 8 : bx)
#define NGW (G * NWAVES)
    for (int u = threadIdx.x; u < (LDS_BYTES - LDSCTL_OFF) / 4; u += NWAVES * 64) ((LAS unsigned*)(lds + LDSCTL_OFF))[u] = 0u;
    __syncthreads();
    (void)xcd_barrier_post((unsigned*)(args_unused.ws + WS_CTL) + CW_BAR, MISC + 8);
#define GRID_BARRIER() do { XcdBarrier b_; b_.bar = (unsigned*)(kargs()->ws + WS_CTL) + CW_BAR; b_.x = xb_xcc_id(); b_.st = (volatile LAS unsigned*)(lds + MISC_OFF) + 8; xcd_barrier(b_); } while (0)

    _Pragma("nounroll") for (int layer = 0; layer < NLAYER; ++layer) {
        if (layer == 0) {
            { PHASE_PROLOG();
              for (int ll = 0; ll < NLAYER; ++ll) { CV_PTRS(P, ka, ws, ll); unsigned* cmi = (unsigned*)(ws + WS_CMAXI) + (size_t)ll * NIN;
                  for (int it = gw; it < 64 * 24; it += NGW) { const int kb = it / 24, cb = it % 24, n0 = cb < 8 ? 256 * cb : (cb < 16 ? COL_RV + 256 * (cb - 8) : COL_AV + 256 * (cb - 16)); colmax_wide(P.w_in, NIN, P.g_mix, 64 * kb, n0, cmi, lane); } }
              const float* x0 = ka->in[0]; const float* x1 = ka->in[1]; pg8::u64_t* SS = (pg8::u64_t*)(ws + WS_SS); bf16* XB = (bf16*)(ws + WS_U); signed char* XQ = (signed char*)(ws + WS_XQ); float* RA = (float*)(ws + WS_RA);
              for (int m = gw; m < M; m += NGW) x_row_in(m < 8192 ? x0 + (size_t)m * D : x1 + (size_t)(m - 8192) * D, XB + (size_t)m * D, SS + m, XQ + (size_t)m * D, RA + m, lane); }
            GRID_BARRIER();
        }
        {
            PHASE_PROLOG();
            bf16* Pbf = (bf16*)(ws + WS_PBF);
            LAS float* scr = (LAS float*)(lds + wave * TR_SCR);
            { CV_PTRS(P, ka, ws, layer);
              for (int it = gw; it < CV_A; it += NGW) convert_item(P, it, scr, lane);
              unsigned* cm = (unsigned*)(ws + WS_CMAX) + (size_t)layer * NGU;
              { constexpr int NB = DFF / 256, NI = 64 * NB;
                for (int it = gw; it < 2 * NI; it += NGW) { const int r = it < NI ? it : it - NI; const int kb = r / NB, n0 = 256 * (r % NB);
                    colmax_wide(it < NI ? P.w_gate : P.w_up, DFF, P.g_ffn, 64 * kb, n0, cm + (it < NI ? 0 : DFF), lane); } }
              unsigned* cmp_ = (unsigned*)(ws + WS_CMAXP) + (size_t)layer * D;
              for (int it = gw; it < 64 * (D / 256); it += NGW) { const int kb = it / (D / 256), n0 = 256 * (it % (D / 256)); colmax_wide(P.w_pg, D, P.g_ple, 64 * kb, n0, cmp_, lane); } }
            { const float* pp0 = ka->in[2] + (size_t)layer * 8192 * PLE; const float* pp1 = ka->in[3] + (size_t)layer * 8192 * PLE;
              for (int i = bx * 512 + tid; i < M * PLE / 4; i += G * 512) { const int e = 4 * i; const float* src = e < 8192 * PLE ? pp0 + e : pp1 + (e - 8192 * PLE);
                  const f32x4 v = __builtin_nontemporal_load((const GAS f32x4*)src); v2u o; o.x = pk2(v.x, v.y); o.y = pk2(v.z, v.w); *(GAS v2u*)(Pbf + e) = o; } }
            if (layer > 0) { const bf16* XBs = (const bf16*)(ws + WS_XB2); signed char* XQ = (signed char*)(ws + WS_XQ); float* RA = (float*)(ws + WS_RA);
                quant_pass(XBs, XQ, RA, gw, NGW, lane); }
        }
        GRID_BARRIER();
        { CArgs* ka = kargs(); unsigned char* ws = ka->ws; pg8::Gemm g{(bf16*)(ws + WS_XQ), (bf16*)(ws + WS_WINQ), M, NQI, D / 2}; pg8::StaticOrder S; S.init(M, NQI, G, bx);
          pg8::EpiStoreHeadsQ E{(bf16*)(ws + WS_Z), M, (const float*)(ws + WS_RA), (const float*)(ws + WS_DBI)};
          pg8::gemm_phase<pg8::EpiStoreHeadsQ, pg8::StaticOrder, true, true, true>(lds, g, S, E); }
        { CArgs* ka = kargs(); unsigned char* ws = ka->ws; pg8::Gemm g{(bf16*)(ws + (layer == 0 ? WS_U : WS_XB2)), (bf16*)(ws + WS_WIN), M, NIN - NQI, D}; pg8::StaticOrder S; S.init(M, NIN - NQI, G, bx);
          pg8::EpiStoreHeads E{(bf16*)(ws + WS_Z), M, (const pg8::u64_t*)(ws + WS_SS) + (size_t)(layer * 3 + 0) * M, ka->in[8] + (size_t)layer * HD, ka->in[9] + (size_t)layer * HD, (LAS float*)(lds + 131072)};
          pg8::gemm_phase<pg8::EpiStoreHeads, pg8::StaticOrder, true, true>(lds, g, S, E); }
        GRID_BARRIER();
        for (int rep = 0; rep < ((DUPMASK & 8) ? 2 : 1); ++rep)
        for (int item = bx; item < 128 + 128; item += G) {
            PHASE_PROLOG();
            const bf16* Z = (const bf16*)(ws + WS_Z); bf16* MIX = (bf16*)(ws + WS_MIX);
            if (item < 128) retention_item(lds, Z, (bf16*)(ws + WS_YF), MIX, ka->in[6] + (size_t)layer * 2 * NH, ka->in[7] + (size_t)layer * 2048, (unsigned long long*)(ws + WS_EXP), (unsigned*)(ws + WS_CTL) + CW_FLAG + 4096 * layer, item, tid);
            else attention_item(lds, Z, (bf16*)(ws + WS_OP), (float*)(ws + WS_LP), MIX, ka->in[8] + (size_t)layer * HD, ka->in[9] + (size_t)layer * HD, item - 128, tid);
        }
        {
            PHASE_PROLOG();
            LAS float* scr = (LAS float*)(lds + wave * TR_SCR);
            unsigned* qhead = (unsigned*)(ws + WS_CTL) + CW_QUEUE + 64 * layer;
            CV_PTRS(P, ka, ws, layer);
            volatile LAS unsigned* qb = (volatile LAS unsigned*)(lds + MISC_OFF) + 2;
            for (;;) {
                __syncthreads();
                if (tid == 0) *qb = atomicAdd(qhead, 32u);
                __syncthreads();
                const int it0 = CV_A + (int)__builtin_amdgcn_readfirstlane(*qb);
                if (it0 >= CV_ALL) break;
                for (int k = 0; k < 4; ++k) { const int it = it0 + 8 * k + wave; if (it < CV_ALL) convert_item(P, it, scr, lane); }
            }
        }
        GRID_BARRIER();
        { CArgs* ka = kargs(); unsigned char* ws = ka->ws; pg8::Gemm g{(bf16*)(ws + WS_MIX), (bf16*)(ws + WS_WOUT), M, D, D}; pg8::StaticOrder S; S.init(M, D, G, bx);
          pg8::EpiResAdd E{(bf16*)(ws + (layer == 0 ? WS_U : WS_XB2)), D};
          pg8::gemm_phase<pg8::EpiResAdd, pg8::StaticOrder, true, true>(lds, g, S, E); }
        GRID_BARRIER();
        { PHASE_PROLOG(); const bf16* XBs = (const bf16*)(ws + (layer == 0 ? WS_U : WS_XB2)); signed char* XQ = (signed char*)(ws + WS_XQ); float* RA = (float*)(ws + WS_RA);
          quant_pass(XBs, XQ, RA, gw, NGW, lane); }
        GRID_BARRIER();
        for (int rep = 0; rep < ((DUPMASK & 64) ? 2 : 1); ++rep)
        { CArgs* ka = kargs(); unsigned char* ws = ka->ws; pg8::Gemm g{(bf16*)(ws + WS_XQ), (bf16*)(ws + WS_WGU), M, NGU, D / 2}; pg8::StaticOrder S; S.init(M, NGU, G, bx);
          pg8::EpiSwiGLUQ E{(bf16*)(ws + WS_Z), DFF, (const float*)(ws + WS_RA), (const float*)(ws + WS_DB)};
          pg8::gemm_phase<pg8::EpiSwiGLUQ, pg8::StaticOrder, true, true, true>(lds, g, S, E); }
        { constexpr int NU_F = (M / 256) * (NGU / 256); const int heavy = NU_F % G;
          { CArgs* ka = kargs(); unsigned char* ws = ka->ws; int Kp = PLE; asm volatile("" : "+s"(Kp)); pg8::Gemm g{(bf16*)(ws + WS_PBF), (bf16*)(ws + WS_WPP), M, D, Kp}; pg8::StaticOrder S; pg8::EpiStoreBf16 E{(bf16*)(ws + WS_PP), D};
            if (heavy > 0 && heavy < G) { const int npp = (M / 256) * (D / 256), cut = (npp * 3 / 4) / (G - heavy) * (G - heavy);
                if (bx >= heavy) { S.init(M, D, G - heavy, bx - heavy); S.lim = cut; } else { S.init(M, D, heavy, bx); S.base = cut; } }
            else S.init(M, D, G, bx);
            pg8::gemm_phase<pg8::EpiStoreBf16, pg8::StaticOrder, true, true>(lds, g, S, E); } }
        GRID_BARRIER();
        { CArgs* ka = kargs(); unsigned char* ws = ka->ws; pg8::Gemm g{(bf16*)(ws + WS_Z), (bf16*)(ws + WS_WDN), M, D, DFF}; pg8::StaticOrder S; S.init(M, D, G, bx);
          pg8::EpiResAdd E{(bf16*)(ws + (layer == 0 ? WS_U : WS_XB2)), D};
          pg8::gemm_phase<pg8::EpiResAdd, pg8::StaticOrder, true, true>(lds, g, S, E); }
        GRID_BARRIER();
        { PHASE_PROLOG(); const bf16* XBs = (const bf16*)(ws + (layer == 0 ? WS_U : WS_XB2)); signed char* XQ = (signed char*)(ws + WS_XQ); float* RA = (float*)(ws + WS_RA);
          quant_pass(XBs, XQ, RA, gw, NGW, lane); }
        GRID_BARRIER();
        if (PHMASK & 256)
        { CArgs* ka = kargs(); unsigned char* ws = ka->ws; const bf16* sb = (const bf16*)(ws + (layer == 0 ? WS_U : WS_XB2)); pg8::Gemm g{(bf16*)(ws + WS_XQ), (bf16*)(ws + WS_WPG), M, D, D / 2}; pg8::StaticOrder S; S.init(M, D, G, bx);
          pg8::EpiPleT<true> E{sb, (const bf16*)(ws + WS_PP), (bf16*)(ws + WS_XB2), nullptr, (const float*)(ws + WS_RA), (const float*)(ws + WS_DBP), (pg8::u64_t*)(ws + WS_SS) + (size_t)((layer * 3 + 3) % 6) * M, layer == NLAYER - 1 ? ka->out : nullptr, D};
          pg8::gemm_phase<pg8::EpiPleT<true>, pg8::StaticOrder, true, true, true>(lds, g, S, E); }
        GRID_BARRIER();
    }
}

#undef G
#undef bx
#undef vcu
#undef NGW
#undef GRID_BARRIER
extern "C" void kernel_launch(void* const* d_in, const int* in_sizes, int n_in, void* d_out, int out_size, void* d_ws, size_t ws_size, hipStream_t stream) {
    static int grid = 0;
    if (grid == 0) {
        if (n_in != 18 || out_size != M * D || ws_size < WS_END) { fprintf(stderr, "kernel_launch: unexpected shapes: n_in %d out %d ws %zu (need %zu)\n", n_in, out_size, ws_size, (size_t)WS_END); grid = -1; return; }
        int dev = 0, cus = 0, per_cu = 0;
        if (hipGetDevice(&dev) != hipSuccess || hipDeviceGetAttribute(&cus, hipDeviceAttributeMultiprocessorCount, dev) != hipSuccess) { grid = -1; return; }
        if (hipFuncSetAttribute((const void*)fwd_kernel, hipFuncAttributeMaxDynamicSharedMemorySize, LDS_BYTES) != hipSuccess) { fprintf(stderr, "kernel_launch: hipFuncSetAttribute failed\n"); grid = -1; return; }
        if (hipOccupancyMaxActiveBlocksPerMultiprocessor(&per_cu, (const void*)fwd_kernel, NWAVES * 64, LDS_BYTES) != hipSuccess || per_cu < 1) fprintf(stderr, "kernel_launch: occupancy query says %d\n", per_cu);
        (void)hipGetLastError();
        grid = cus;
    }
    if (grid < 0) return;
    if (hipMemsetAsync((char*)d_ws + WS_CTL, 0, CTL_ZERO_BYTES, stream) != hipSuccess) return;
    Args a{};
    for (int i = 0; i < 18; ++i) a.in[i] = (const float*)d_in[i];
    a.out = (float*)d_out; a.ws = (unsigned char*)d_ws;
    hipLaunchKernelGGL(fwd_kernel, dim3(grid), dim3(NWAVES * 64), LDS_BYTES, stream, a);
}
```

```cpp
#include <hip/hip_runtime.h>
#include <cstdio>
#include <cstdint>

__device__ __forceinline__ int opaque_tid() { int t = threadIdx.x; asm volatile("" : "+v"(t)); return t; }
template <class T> __device__ __forceinline__ T* opaque_ptr(T* p) { asm volatile("" : "+s"(p)); return p; }
namespace pg8 {
#define PG8_LAS __attribute__((address_space(3)))
typedef unsigned short bf16_t;
typedef short bf16x8 __attribute__((ext_vector_type(8)));
typedef float f32x4 __attribute__((ext_vector_type(4)));
typedef int i32x4 __attribute__((ext_vector_type(4)));
typedef unsigned u32x4 __attribute__((ext_vector_type(4)));
typedef unsigned u32x2 __attribute__((ext_vector_type(2)));
constexpr int BM = 256, BK = 64, HALF = 128, HTB = HALF * BK * 2, STAGE_BYTES = 8 * HTB, NXCD = 8, WGM = 8;

__host__ __device__ __forceinline__ int lds_byte(int r, int c) { const int st = (r >> 4) * 2 + (c >> 5), rr = r & 15, cc = c & 31, ob = rr * 64 + cc * 2; return st * 1024 + (ob ^ (((ob >> 9) & 1) << 5)); }
__host__ __device__ __forceinline__ void stage_rc(int b, int& R, int& C) { const int st = b / 1024, sb = b % 1024, swz = sb ^ (((sb >> 9) & 1) << 5); R = (st >> 1) * 16 + swz / 64; C = (st & 1) * 32 + (swz % 64) / 2; }
__host__ __device__ __forceinline__ int perm32(int rho) { const int n = rho >> 4, i = rho & 15; return 8 * (i >> 2) + 4 * n + (i & 3); }

struct Unit { int pm, pn; };
struct Gemm { const bf16_t* A; const bf16_t* Bt; int M, N, K; };

struct StaticOrder {
    int nM, nN, nwg, G, c, base, lim, tr;
    __host__ __device__ void init(int M, int N, int G_, int c_) { nM = M / BM; nN = N / BM; nwg = nM * nN; G = G_; c = c_; base = 0; lim = nwg; tr = 0; }
    __host__ __device__ bool next(int i, Unit& u) const {
        const long L = (long)base + (long)i * G + c; if (L >= lim) return false;
        int wgid = (int)L; { const int q = nwg / NXCD, r = nwg % NXCD, xcd = wgid % NXCD, off = wgid / NXCD; wgid = (xcd < r ? xcd * (q + 1) : r * (q + 1) + (xcd - r) * q) + off; }
        const int M_ = tr ? nN : nM, N_ = tr ? nM : nN;
        const int nig = WGM * N_, gid = wgid / nig, fm = gid * WGM, gsz = (M_ - fm) < WGM ? (M_ - fm) : WGM;
        const int a_ = fm + ((wgid % nig) % gsz), b_ = (wgid % nig) / gsz;
        u.pm = tr ? b_ : a_; u.pn = tr ? a_ : b_; return true;
    }
    __device__ __forceinline__ void a_ready(const Unit&) const {}
    __device__ __forceinline__ void done(const Unit&) const {}
};

__device__ __forceinline__ unsigned cvt_pk_bf16(float lo, float hi) { unsigned r; asm volatile("v_cvt_pk_bf16_f32 %0, %1, %2" : "=v"(r) : "v"(lo), "v"(hi)); return r; }
__device__ __forceinline__ float fast_sigmoid(float x) { return __builtin_amdgcn_rcpf(1.0f + __expf(-x)); }

struct EpiStoreBf16 {
    static constexpr bool PERM = true, AFTER_DRAIN = false;
    bf16_t* O; int ldc;
    __device__ __forceinline__ void operator()(const f32x4 (&acc)[2][2][4][2], const Unit& u, int wr, int wc, int fr, int fq) const {
        const int row0 = u.pm * BM + wr * 64 + fr, col0 = u.pn * BM + wc * 32 + 8 * fq;
#pragma unroll
        for (int ai = 0; ai < 2; ++ai)
#pragma unroll
            for (int m = 0; m < 4; ++m) { bf16_t* rowp = O + (size_t)(row0 + ai * HALF + m * 16) * ldc + col0;
#pragma unroll
                for (int bj = 0; bj < 2; ++bj) { const f32x4 v0 = acc[ai][bj][m][0], v1 = acc[ai][bj][m][1];
                    u32x4 w; w.x = cvt_pk_bf16(v0[0], v0[1]); w.y = cvt_pk_bf16(v0[2], v0[3]); w.z = cvt_pk_bf16(v1[0], v1[1]); w.w = cvt_pk_bf16(v1[2], v1[3]);
                    *(u32x4*)(rowp + bj * HALF) = w; } }
    }
};
typedef unsigned long long u64_t;
__device__ __forceinline__ u64_t ss_fix(float ss) { return (u64_t)(ss * 1048576.0f + 0.5f); }
__device__ __forceinline__ float ss_rs(u64_t v) { return 1.0f / sqrtf((float)v * (1.0f / (1048576.0f * 4096.0f)) + 1e-6f); }
__device__ __forceinline__ float row_rs(const u64_t* SS, int row) { return ss_rs(SS[row]); }
struct EpiStoreHeads {
    static constexpr bool PERM = true, AFTER_DRAIN = false;
    bf16_t* O; int Mrows; const u64_t* SS; const float* qg; const float* kg; PG8_LAS float* T;
    __device__ __forceinline__ void operator()(const f32x4 (&acc)[2][2][4][2], const Unit& u, int wr, int wc, int fr, int fq) const {
        const int row0 = u.pm * BM + wr * 64 + fr, col0 = wc * 32 + 8 * fq;
        const bool qk = 2 * u.pn >= 32;
        float rsv[2][4];
        { u64_t ssv[2][4];
#pragma unroll
          for (int ai = 0; ai < 2; ++ai)
#pragma unroll
              for (int m = 0; m < 4; ++m) ssv[ai][m] = SS[row0 + ai * HALF + m * 16];
          __builtin_amdgcn_sched_barrier(0);
#pragma unroll
          for (int ai = 0; ai < 2; ++ai)
#pragma unroll
              for (int m = 0; m < 4; ++m) rsv[ai][m] = __builtin_amdgcn_rsqf((float)ssv[ai][m] * (1.0f / (1048576.0f * 4096.0f)) + 1e-6f); }
        if (qk) {
            float sp[2][4][2];
#pragma unroll
            for (int ai = 0; ai < 2; ++ai)
#pragma unroll
                for (int m = 0; m < 4; ++m) { const float rs = rsv[ai][m];
#pragma unroll
                    for (int bj = 0; bj < 2; ++bj) { const f32x4 v0 = acc[ai][bj][m][0] * rs, v1 = acc[ai][bj][m][1] * rs;
                        sp[ai][m][bj] = ((v0[0] * v0[0] + v0[1] * v0[1]) + (v0[2] * v0[2] + v0[3] * v0[3])) + ((v1[0] * v1[0] + v1[1] * v1[1]) + (v1[2] * v1[2] + v1[3] * v1[3])); } }
            float t1[2][4][2];
#pragma unroll
            for (int ai = 0; ai < 2; ++ai)
#pragma unroll
                for (int m = 0; m < 4; ++m)
#pragma unroll
                    for (int bj = 0; bj < 2; ++bj) t1[ai][m][bj] = __shfl_xor(sp[ai][m][bj], 16);
#pragma unroll
            for (int ai = 0; ai < 2; ++ai)
#pragma unroll
                for (int m = 0; m < 4; ++m)
#pragma unroll
                    for (int bj = 0; bj < 2; ++bj) sp[ai][m][bj] += t1[ai][m][bj];
#pragma unroll
            for (int ai = 0; ai < 2; ++ai)
#pragma unroll
                for (int m = 0; m < 4; ++m)
#pragma unroll
                    for (int bj = 0; bj < 2; ++bj) t1[ai][m][bj] = __shfl_xor(sp[ai][m][bj], 32);
            if (fq == 0) {
#pragma unroll
                for (int ai = 0; ai < 2; ++ai)
#pragma unroll
                    for (int m = 0; m < 4; ++m) { const int rt = ai * HALF + wr * 64 + m * 16 + fr;
#pragma unroll
                        for (int bj = 0; bj < 2; ++bj) T[(rt * 2 + bj) * 4 + wc] = sp[ai][m][bj] + t1[ai][m][bj]; } }
            asm volatile("s_waitcnt lgkmcnt(0)" ::: "memory"); __builtin_amdgcn_s_barrier(); asm volatile("" ::: "memory");
        }
        const bool isq = 2 * u.pn < 48;
        const float* gp = (isq ? qg : kg) + col0; const float sc = isq ? 0.08838834764831845f : 1.0f;
        f32x4 g0 = (f32x4){1.f, 1.f, 1.f, 1.f}, g1 = g0;
        if (qk) { g0 = *(const f32x4*)gp; g1 = *(const f32x4*)(gp + 4); }
#pragma unroll
        for (int ai = 0; ai < 2; ++ai)
#pragma unroll
            for (int m = 0; m < 4; ++m) { const int row = row0 + ai * HALF + m * 16; const float rs = rsv[ai][m]; const int rt = ai * HALF + wr * 64 + m * 16 + fr;
#pragma unroll
                for (int bj = 0; bj < 2; ++bj) { f32x4 v0 = acc[ai][bj][m][0] * rs, v1 = acc[ai][bj][m][1] * rs;
                    if (qk) { const f32x4 t = *(const PG8_LAS f32x4*)(T + (rt * 2 + bj) * 4);
                        const float rn = __builtin_amdgcn_rsqf(((t[0] + t[1]) + (t[2] + t[3])) * (1.f / 128.f) + 1e-6f) * sc;
                        v0 = (v0 * rn) * g0; v1 = (v1 * rn) * g1; }
                    u32x4 w; w.x = cvt_pk_bf16(v0[0], v0[1]); w.y = cvt_pk_bf16(v0[2], v0[3]); w.z = cvt_pk_bf16(v1[0], v1[1]); w.w = cvt_pk_bf16(v1[2], v1[3]);
                    const int pc = 2 * u.pn + bj, pl = pc + (pc < 16 ? 16 : 32);
                    *(u32x4*)(O + ((size_t)pl * Mrows + row) * HALF + col0) = w; } }
    }
};
struct EpiStoreHeadsQ {
    static constexpr bool PERM = true, AFTER_DRAIN = false;
    bf16_t* O; int Mrows; const float* RA; const float* DB;
    __device__ __forceinline__ void operator()(const i32x4 (&acc)[2][2][4][2], const Unit& u, int wr, int wc, int fr, int fq) const {
        const int row0 = u.pm * BM + wr * 64 + fr, col0 = wc * 32 + 8 * fq, bcol = u.pn * BM + wc * 32 + 8 * fq;
        f32x4 db[2][2];
#pragma unroll
        for (int bj = 0; bj < 2; ++bj) { db[bj][0] = *(const f32x4*)(DB + bcol + bj * HALF); db[bj][1] = *(const f32x4*)(DB + bcol + bj * HALF + 4); }
        float rav[2][4];
#pragma unroll
        for (int ai = 0; ai < 2; ++ai)
#pragma unroll
            for (int m = 0; m < 4; ++m) rav[ai][m] = RA[row0 + ai * HALF + m * 16];
        __builtin_amdgcn_sched_barrier(0);
#pragma unroll
        for (int ai = 0; ai < 2; ++ai)
#pragma unroll
            for (int m = 0; m < 4; ++m) { const int row = row0 + ai * HALF + m * 16; const float ra = rav[ai][m];
#pragma unroll
                for (int bj = 0; bj < 2; ++bj) { float v[8];
#pragma unroll
                    for (int j = 0; j < 4; ++j) { v[j] = (float)acc[ai][bj][m][0][j] * ra * db[bj][0][j]; v[4 + j] = (float)acc[ai][bj][m][1][j] * ra * db[bj][1][j]; }
                    u32x4 w; w.x = cvt_pk_bf16(v[0], v[1]); w.y = cvt_pk_bf16(v[2], v[3]); w.z = cvt_pk_bf16(v[4], v[5]); w.w = cvt_pk_bf16(v[6], v[7]);
                    const int pc = 2 * u.pn + bj, pl = pc < 16 ? pc : (pc < 32 ? 16 + pc : 64 + pc);
                    *(u32x4*)(O + ((size_t)pl * Mrows + row) * HALF + col0) = w; } }
    }
};
__device__ __forceinline__ void unpack8(const u32x4 w, f32x4& a, f32x4& b) { a[0] = __uint_as_float(w.x << 16); a[1] = __uint_as_float(w.x & 0xffff0000u); a[2] = __uint_as_float(w.y << 16); a[3] = __uint_as_float(w.y & 0xffff0000u);
    b[0] = __uint_as_float(w.z << 16); b[1] = __uint_as_float(w.z & 0xffff0000u); b[2] = __uint_as_float(w.w << 16); b[3] = __uint_as_float(w.w & 0xffff0000u); }
struct EpiResAdd {
    static constexpr bool PERM = true, AFTER_DRAIN = false;
    bf16_t* XB; int ldc;
    __device__ __forceinline__ void operator()(const f32x4 (&acc)[2][2][4][2], const Unit& u, int wr, int wc, int fr, int fq) const {
        const int row0 = u.pm * BM + wr * 64 + fr, col0 = u.pn * BM + wc * 32 + 8 * fq;
        u32x4 xv[2][4][2];
#pragma unroll
        for (int ai = 0; ai < 2; ++ai)
#pragma unroll
            for (int m = 0; m < 4; ++m)
#pragma unroll
                for (int bj = 0; bj < 2; ++bj) xv[ai][m][bj] = *(const u32x4*)(XB + (size_t)(row0 + ai * HALF + m * 16) * ldc + col0 + bj * HALF);
#pragma unroll
        for (int ai = 0; ai < 2; ++ai) {
#pragma unroll
            for (int m = 0; m < 4; ++m) { const int row = row0 + ai * HALF + m * 16;
#pragma unroll
                for (int bj = 0; bj < 2; ++bj) { f32x4 v0, v1; unpack8(xv[ai][m][bj], v0, v1); v0 = v0 + acc[ai][bj][m][0]; v1 = v1 + acc[ai][bj][m][1];
                    u32x4 w; w.x = cvt_pk_bf16(v0[0], v0[1]); w.y = cvt_pk_bf16(v0[2], v0[3]); w.z = cvt_pk_bf16(v1[0], v1[1]); w.w = cvt_pk_bf16(v1[2], v1[3]);
                    *(u32x4*)(XB + (size_t)row * ldc + col0 + bj * HALF) = w; } }
            asm volatile("" ::: "memory"); }
    }
};
struct EpiSwiGLUQ {
    static constexpr bool PERM = true, AFTER_DRAIN = false;
    bf16_t* H; int ldh; const float* RA; const float* DB;
    __device__ __forceinline__ void operator()(const i32x4 (&acc)[2][2][4][2], const Unit& u, int wr, int wc, int fr, int fq) const {
        const int row0 = u.pm * BM + wr * 64 + fr, col0 = u.pn * HALF + wc * 32 + 8 * fq, brow = u.pn * BM + wc * 32 + 8 * fq;
        const f32x4 dg0 = *(const f32x4*)(DB + brow), dg1 = *(const f32x4*)(DB + brow + 4), du0 = *(const f32x4*)(DB + brow + HALF), du1 = *(const f32x4*)(DB + brow + HALF + 4);
        float rav[2][4];
#pragma unroll
        for (int ai = 0; ai < 2; ++ai)
#pragma unroll
            for (int m = 0; m < 4; ++m) rav[ai][m] = RA[row0 + ai * HALF + m * 16];
        __builtin_amdgcn_sched_barrier(0);
#pragma unroll
        for (int ai = 0; ai < 2; ++ai)
#pragma unroll
            for (int m = 0; m < 4; ++m) { const int row = row0 + ai * HALF + m * 16; const float ra = rav[ai][m]; bf16_t* rowp = H + (size_t)row * ldh + col0;
                float hv[8];
#pragma unroll
                for (int j = 0; j < 4; ++j) { const float g0 = (float)acc[ai][0][m][0][j] * ra * dg0[j], u0 = (float)acc[ai][1][m][0][j] * ra * du0[j]; hv[j] = g0 * fast_sigmoid(g0) * u0;
                    const float g1 = (float)acc[ai][0][m][1][j] * ra * dg1[j], u1 = (float)acc[ai][1][m][1][j] * ra * du1[j]; hv[4 + j] = g1 * fast_sigmoid(g1) * u1; }
                u32x4 w; w.x = cvt_pk_bf16(hv[0], hv[1]); w.y = cvt_pk_bf16(hv[2], hv[3]); w.z = cvt_pk_bf16(hv[4], hv[5]); w.w = cvt_pk_bf16(hv[6], hv[7]);
                *(u32x4*)rowp = w; }
    }
};
struct EpiSwiGLU {
    static constexpr bool PERM = true, AFTER_DRAIN = false;
    bf16_t* H; int ldh; const u64_t* SS;
    __device__ __forceinline__ void operator()(const f32x4 (&acc)[2][2][4][2], const Unit& u, int wr, int wc, int fr, int fq) const {
        const int row0 = u.pm * BM + wr * 64 + fr, col0 = u.pn * HALF + wc * 32 + 8 * fq;
#pragma unroll
        for (int ai = 0; ai < 2; ++ai)
#pragma unroll
            for (int m = 0; m < 4; ++m) { const int row = row0 + ai * HALF + m * 16; const float rs = row_rs(SS, row); bf16_t* rowp = H + (size_t)row * ldh + col0;
                float hv[8];
#pragma unroll
                for (int n = 0; n < 2; ++n)
#pragma unroll
                    for (int j = 0; j < 4; ++j) { const float g = acc[ai][0][m][n][j] * rs, up = acc[ai][1][m][n][j] * rs; hv[4 * n + j] = g * fast_sigmoid(g) * up; }
                u32x4 w; w.x = cvt_pk_bf16(hv[0], hv[1]); w.y = cvt_pk_bf16(hv[2], hv[3]); w.z = cvt_pk_bf16(hv[4], hv[5]); w.w = cvt_pk_bf16(hv[6], hv[7]);
                *(u32x4*)rowp = w; }
    }
};
template <bool Q> struct EpiPleT {
    static constexpr bool PERM = true, AFTER_DRAIN = false;
    const bf16_t* XBi; const bf16_t* PP; bf16_t* XBo; const u64_t* SS; const float* RA; const float* DB; u64_t* SSo; float* OUT; int ldc;
    template <class ACC> __device__ __forceinline__ void operator()(const ACC (&acc)[2][2][4][2], const Unit& u, int wr, int wc, int fr, int fq) const {
        const int row0 = u.pm * BM + wr * 64 + fr, col0 = u.pn * BM + wc * 32 + 8 * fq;
        f32x4 db[2][2];
        if constexpr (Q) {
#pragma unroll
            for (int bj = 0; bj < 2; ++bj) { db[bj][0] = *(const f32x4*)(DB + col0 + bj * HALF); db[bj][1] = *(const f32x4*)(DB + col0 + bj * HALF + 4); } }
#pragma unroll
        for (int ai = 0; ai < 2; ++ai)
#pragma unroll
          for (int mp = 0; mp < 2; ++mp) {
            u32x4 xv[2][2], pv[2][2]; float rsv[2];
#pragma unroll
            for (int mm = 0; mm < 2; ++mm) { const int row = row0 + ai * HALF + (2 * mp + mm) * 16; if constexpr (Q) rsv[mm] = RA[row]; else rsv[mm] = ss_rs(SS[row]);
#pragma unroll
                for (int bj = 0; bj < 2; ++bj) { xv[mm][bj] = *(const u32x4*)(XBi + (size_t)row * ldc + col0 + bj * HALF); pv[mm][bj] = *(const u32x4*)(PP + (size_t)row * ldc + col0 + bj * HALF); } }
#pragma unroll
            for (int mm = 0; mm < 2; ++mm) { const int m = 2 * mp + mm, row = row0 + ai * HALF + m * 16; float ss = 0.f; const float rs = rsv[mm];
#pragma unroll
                for (int bj = 0; bj < 2; ++bj) { f32x4 v0, v1, p0, p1; unpack8(xv[mm][bj], v0, v1); unpack8(pv[mm][bj], p0, p1); f32x4 a0, a1;
#pragma unroll
                    for (int j = 0; j < 4; ++j) { if constexpr (Q) { a0[j] = (float)acc[ai][bj][m][0][j] * rs * db[bj][0][j]; a1[j] = (float)acc[ai][bj][m][1][j] * rs * db[bj][1][j]; }
                                                  else { a0[j] = (float)acc[ai][bj][m][0][j] * rs; a1[j] = (float)acc[ai][bj][m][1][j] * rs; } }
#pragma unroll
                    for (int j = 0; j < 4; ++j) { v0[j] += fast_sigmoid(a0[j]) * p0[j]; v1[j] += fast_sigmoid(a1[j]) * p1[j]; }
                    if (OUT) { float* p = OUT + (size_t)row * ldc + col0 + bj * HALF; *(f32x4*)p = v0; *(f32x4*)(p + 4) = v1; }
                    else { u32x4 w; w.x = cvt_pk_bf16(v0[0], v0[1]); w.y = cvt_pk_bf16(v0[2], v0[3]); w.z = cvt_pk_bf16(v1[0], v1[1]); w.w = cvt_pk_bf16(v1[2], v1[3]);
                        *(u32x4*)(XBo + (size_t)row * ldc + col0 + bj * HALF) = w; unpack8(w, v0, v1);
                        ss += ((v0[0] * v0[0] + v0[1] * v0[1]) + (v0[2] * v0[2] + v0[3] * v0[3])) + ((v1[0] * v1[0] + v1[1] * v1[1]) + (v1[2] * v1[2] + v1[3] * v1[3])); } }
                if (!OUT) { ss += __shfl_xor(ss, 16); ss += __shfl_xor(ss, 32); if (fq == 0) atomicAdd(SSo + row, ss_fix(ss)); } }
            asm volatile("" ::: "memory"); }
    }
};

template <bool I8> struct AccT { typedef f32x4 type; }; template <> struct AccT<true> { typedef i32x4 type; };
template <class Epi, class Sched, bool ALIGN_EPI = false, bool SP2 = false, bool I8 = false>
__device__ __forceinline__ void gemm_phase(PG8_LAS unsigned char* lds, const Gemm g, const Sched& S, const Epi& E) {
    const int tid = opaque_tid(), wid = __builtin_amdgcn_readfirstlane(tid >> 6), lane = tid & 63, wr = wid >> 2, wc = wid & 3, fr = lane & 15, fq = lane >> 4;
    const int K = g.K, nt = K / BK;
    unsigned voffA[2], voffB[2];
#pragma unroll
    for (int i = 0; i < 2; ++i) { int R, C; stage_rc(tid * 16 + i * 8192, R, C); const int Rb = Epi::PERM ? ((R & ~31) + perm32(R & 31)) : R;
        voffA[i] = (unsigned)(R * K + C) * 2u; voffB[i] = (unsigned)(Rb * K + C) * 2u; }
    const size_t kstep = (size_t)(BK * 2);
    const size_t hstep = (size_t)HALF * K * 2;
    const size_t tstep = 2 * hstep;
    const unsigned ldsw = (unsigned)wid * 1024u;
    const int aoff = lds_byte(wr * 64 + fr, fq * 8), boff = lds_byte(wc * 32 + fr, fq * 8);
#define PG8_SA(b, h) (((b) * 2 + (h)) * HTB)
#define PG8_SB(b, h) ((4 + (b) * 2 + (h)) * HTB)
#define PG8_STAGE(bufoff, gbase, voff) do { _Pragma("unroll") for (int _i = 0; _i < 2; ++_i) \
        __builtin_amdgcn_global_load_lds((const unsigned*)((const char*)(gbase) + (voff)[_i]), (PG8_LAS unsigned*)(lds + (bufoff) + ldsw + _i * 8192), 16, 0, 0); } while (0)
#define PG8_LDA(dst, b, h) do { _Pragma("unroll") for (int m = 0; m < 4; ++m) _Pragma("unroll") for (int k = 0; k < 2; ++k) dst[m][k] = *(const PG8_LAS bf16x8*)(lds + PG8_SA(b, h) + aoff + m * 2048 + k * 1024); } while (0)
#define PG8_LDB(dst, b, h) do { _Pragma("unroll") for (int n = 0; n < 2; ++n) _Pragma("unroll") for (int k = 0; k < 2; ++k) dst[n][k] = *(const PG8_LAS bf16x8*)(lds + PG8_SB(b, h) + boff + n * 2048 + k * 1024); } while (0)
#define PG8_MMA(ai, bj, At, Bt) do { __builtin_amdgcn_s_setprio(1); _Pragma("unroll") for (int m = 0; m < 4; ++m) _Pragma("unroll") for (int n = 0; n < 2; ++n) _Pragma("unroll") for (int k = 0; k < 2; ++k) { \
        if constexpr (I8) acc[ai][bj][m][n] = __builtin_amdgcn_mfma_i32_16x16x64_i8(__builtin_bit_cast(i32x4, Bt[n][k]), __builtin_bit_cast(i32x4, At[m][k]), acc[ai][bj][m][n], 0, 0, 0); \
        else acc[ai][bj][m][n] = __builtin_amdgcn_mfma_f32_16x16x32_bf16(Bt[n][k], At[m][k], acc[ai][bj][m][n], 0, 0, 0); } __builtin_amdgcn_s_setprio(0); } while (0)
#define PG8_WAIT_V(n) asm volatile("s_waitcnt vmcnt(" #n ")" ::: "memory")
#define PG8_WAIT_L(n) asm volatile("s_waitcnt lgkmcnt(" #n ")" ::: "memory")
#define PG8_BAR __builtin_amdgcn_s_barrier()
#define PG8_SCHED __builtin_amdgcn_sched_barrier(0)
    Unit cur, nxt; int ui = 0;
    if (!S.next(0, cur)) return;
    typedef typename AccT<I8>::type acc_t;
    acc_t acc[2][2][4][2];
#pragma unroll
    for (int a = 0; a < 2; ++a)
#pragma unroll
        for (int b = 0; b < 2; ++b)
#pragma unroll
            for (int m = 0; m < 4; ++m)
#pragma unroll
                for (int n = 0; n < 2; ++n) acc[a][b][m][n] = (acc_t){0, 0, 0, 0};
    bf16x8 At[4][2], B0[2][2], B1[2][2];
    const char* cA = (const char*)g.A + (size_t)cur.pm * tstep; const char* cB = (const char*)g.Bt + (size_t)cur.pn * tstep;
    S.a_ready(cur);
    if constexpr (SP2) {
        PG8_STAGE(PG8_SB(0, 0), cB, voffB); PG8_STAGE(PG8_SB(0, 1), cB + hstep, voffB); PG8_STAGE(PG8_SA(0, 0), cA, voffA); PG8_STAGE(PG8_SA(0, 1), cA + hstep, voffA);
        if (wr == 1) PG8_BAR;
        PG8_WAIT_V(2); PG8_BAR;
        PG8_STAGE(PG8_SB(1, 0), cB + kstep, voffB); PG8_STAGE(PG8_SA(1, 0), cA + kstep, voffA); PG8_STAGE(PG8_SB(1, 1), cB + hstep + kstep, voffB);
        PG8_WAIT_V(6); PG8_BAR;
    } else {
        PG8_STAGE(PG8_SB(0, 0), cB, voffB); PG8_STAGE(PG8_SA(0, 0), cA, voffA); PG8_STAGE(PG8_SB(0, 1), cB + hstep, voffB); PG8_STAGE(PG8_SA(0, 1), cA + hstep, voffA);
        if (wr == 1) PG8_BAR;
        PG8_WAIT_V(4); PG8_BAR;
        PG8_STAGE(PG8_SB(1, 0), cB + kstep, voffB); PG8_STAGE(PG8_SA(1, 0), cA + kstep, voffA); PG8_STAGE(PG8_SB(1, 1), cB + hstep + kstep, voffB);
        PG8_WAIT_V(6); PG8_BAR;
    }
    for (;;) {
        const bool has_next = S.next(ui + 1, nxt);
        const char* nA = has_next ? (const char*)g.A + (size_t)nxt.pm * tstep : cA; const char* nB = has_next ? (const char*)g.Bt + (size_t)nxt.pn * tstep : cB;
        for (int t = 0; t < nt; t += 2) {
            const bool last = (t == nt - 2);
            const char* a1 = cA + (size_t)(t + 1) * kstep;
            const char* a2 = last ? nA : cA + (size_t)(t + 2) * kstep; const char* b2 = last ? nB : cB + (size_t)(t + 2) * kstep;
            const char* a3 = a2 + kstep; const char* b3 = b2 + kstep;
            if (last && has_next) S.a_ready(nxt);
            if constexpr (SP2) {
            PG8_LDB(B0, 0, 0); PG8_LDB(B1, 0, 1); PG8_SCHED; PG8_LDA(At, 0, 0); PG8_STAGE(PG8_SA(1, 1), a1 + hstep, voffA);
            PG8_WAIT_V(8); PG8_WAIT_L(0); PG8_BAR; PG8_MMA(0, 0, At, B0); PG8_MMA(0, 1, At, B1); PG8_BAR; PG8_SCHED;
            PG8_LDA(At, 0, 1); PG8_STAGE(PG8_SB(0, 0), b2, voffB); PG8_STAGE(PG8_SB(0, 1), b2 + hstep, voffB); PG8_STAGE(PG8_SA(0, 0), a2, voffA);
            PG8_WAIT_V(8); PG8_WAIT_L(0); PG8_BAR; PG8_MMA(1, 0, At, B0); PG8_MMA(1, 1, At, B1); PG8_BAR; PG8_SCHED;
            PG8_LDB(B0, 1, 0); PG8_LDB(B1, 1, 1); PG8_SCHED; PG8_LDA(At, 1, 0); PG8_STAGE(PG8_SA(0, 1), a2 + hstep, voffA);
            PG8_WAIT_V(8); PG8_WAIT_L(0); PG8_BAR; PG8_MMA(0, 0, At, B0); PG8_MMA(0, 1, At, B1); PG8_BAR; PG8_SCHED;
            PG8_LDA(At, 1, 1); PG8_STAGE(PG8_SB(1, 0), b3, voffB); PG8_STAGE(PG8_SB(1, 1), b3 + hstep, voffB); PG8_STAGE(PG8_SA(1, 0), a3, voffA);
            PG8_WAIT_V(8); PG8_WAIT_L(0); PG8_BAR; PG8_MMA(1, 0, At, B0); PG8_MMA(1, 1, At, B1); PG8_BAR; PG8_SCHED;
            } else {
            PG8_LDB(B0, 0, 0); PG8_SCHED; PG8_LDA(At, 0, 0); PG8_STAGE(PG8_SA(1, 1), a1 + hstep, voffA);
            PG8_WAIT_L(8); PG8_BAR; PG8_WAIT_L(0); PG8_MMA(0, 0, At, B0); PG8_BAR; PG8_SCHED;
            PG8_LDB(B1, 0, 1); PG8_STAGE(PG8_SB(0, 0), b2, voffB);
            PG8_BAR; PG8_WAIT_L(0); PG8_MMA(0, 1, At, B1); PG8_BAR;
            PG8_LDA(At, 0, 1); PG8_STAGE(PG8_SA(0, 0), a2, voffA);
            PG8_BAR; PG8_WAIT_L(0); PG8_MMA(1, 0, At, B0); PG8_BAR; PG8_SCHED;
            PG8_STAGE(PG8_SB(0, 1), b2 + hstep, voffB);
            PG8_WAIT_V(6); PG8_BAR; PG8_MMA(1, 1, At, B1); PG8_BAR;
            PG8_LDB(B0, 1, 0); PG8_SCHED; PG8_LDA(At, 1, 0); PG8_STAGE(PG8_SA(0, 1), a2 + hstep, voffA);
            PG8_WAIT_L(8); PG8_BAR; PG8_WAIT_L(0); PG8_MMA(0, 0, At, B0); PG8_BAR; PG8_SCHED;
            PG8_LDB(B1, 1, 1); PG8_STAGE(PG8_SB(1, 0), b3, voffB);
            PG8_BAR; PG8_WAIT_L(0); PG8_MMA(0, 1, At, B1); PG8_BAR;
            PG8_LDA(At, 1, 1); PG8_STAGE(PG8_SA(1, 0), a3, voffA);
            PG8_BAR; PG8_WAIT_L(0); PG8_MMA(1, 0, At, B0); PG8_BAR; PG8_SCHED;
            PG8_STAGE(PG8_SB(1, 1), b3 + hstep, voffB);
            PG8_WAIT_V(6); PG8_BAR; PG8_MMA(1, 1, At, B1); PG8_BAR;
            }
        }
        if constexpr (ALIGN_EPI) { if (wr == 0) PG8_BAR; }
        if constexpr (!Epi::AFTER_DRAIN) { E(acc, cur, wr, wc, fr, fq); S.done(cur); }
        if (!has_next) break;
#pragma unroll
        for (int a = 0; a < 2; ++a)
#pragma unroll
            for (int b = 0; b < 2; ++b)
#pragma unroll
                for (int m = 0; m < 4; ++m)
#pragma unroll
                    for (int n = 0; n < 2; ++n) acc[a][b][m][n] = (acc_t){0, 0, 0, 0};
        cur = nxt; cA = nA; cB = nB; ++ui;
        if constexpr (ALIGN_EPI) { if (wr == 1) PG8_BAR; }
    }
    PG8_WAIT_V(0);
    if constexpr (!ALIGN_EPI) { if (wr == 0) PG8_BAR; }
    PG8_BAR;
#undef PG8_SA
#undef PG8_SB
#undef PG8_STAGE
#undef PG8_LDA
#undef PG8_LDB
#undef PG8_MMA
#undef PG8_WAIT_V
#undef PG8_WAIT_L
#undef PG8_BAR
#undef PG8_SCHED
}
}

constexpr int NWAVES = 8;
constexpr int D = 4096, M = 16384, NIN = 14336, DFF = 11008, NGU = 2 * DFF, PLE = 256, HD = 128, NH = 16;
constexpr int COL_RQ = 0, COL_RK = 2048, COL_RV = 4096, COL_RG = 6144, COL_AQ = 8192, COL_AK = 10240, COL_AV = 12288;
constexpr float RMS_EPS = 1e-6f, GN_EPS = 1e-5f;

constexpr size_t MiB = 1u << 20;
constexpr size_t WS_CTL = 0, CTL_ZERO_BYTES = 2 * MiB;
constexpr size_t WS_WIN = 2 * MiB;
constexpr size_t WS_WOUT = WS_WIN + (size_t)NIN * D * 2;
constexpr size_t WS_WGU = WS_WOUT + (size_t)D * D * 2;
constexpr size_t WS_WDN = WS_WGU + (size_t)NGU * D * 2;
constexpr size_t WS_WPG = WS_WDN + (size_t)D * DFF * 2;
constexpr size_t WS_WPP = WS_WPG + (size_t)D * D * 2;
constexpr size_t WS_PBF = WS_WPP + (size_t)D * PLE * 2;
constexpr size_t WS_U = WS_PBF + (size_t)M * PLE * 2;
constexpr size_t WS_MIX = WS_U + (size_t)M * D * 2;
constexpr size_t WS_PP = WS_MIX + (size_t)M * D * 2;
constexpr size_t WS_Z = WS_PP + (size_t)M * D * 2;
constexpr size_t WS_YF = WS_Z + (size_t)M * NIN * 2;
constexpr size_t WS_OP = WS_YF + (size_t)M * 2048 * 4;
constexpr size_t WS_LP = WS_OP + (size_t)3 * M * 2048 * 2;
constexpr size_t WS_XB2 = WS_LP + (size_t)3 * NH * M * 4;
constexpr size_t WS_EXP = WS_XB2 + (size_t)M * D * 2;
constexpr size_t WS_RA = WS_EXP + (size_t)64 * 65536;
constexpr size_t WS_DB = WS_RA + (size_t)M * 4;
constexpr size_t WS_DBP = WS_DB + (size_t)NGU * 4;
constexpr int NQI = 6144;
constexpr size_t WS_DBI = WS_DBP + (size_t)D * 4;
constexpr size_t WS_WINQ = WS_DBI + (size_t)NQI * 4;
constexpr size_t WS_END = WS_WINQ + (size_t)NQI * D;
constexpr size_t WS_XQ = WS_OP + (size_t)2 * M * 2048 * 2;
constexpr size_t WS_CMAX = 256 * 1024, WS_RMAX = 512 * 1024;
constexpr size_t WS_CMAXI = 512 * 1024;
constexpr size_t WS_RMAXG = 640 * 1024, WS_CMAXP = 768 * 1024;
static_assert(WS_CMAX + 2 * (size_t)NGU * 4 <= WS_RMAX && WS_RMAX + 2 * (size_t)M * 4 <= WS_RMAXG && WS_RMAXG + 2 * (size_t)M * 4 <= WS_CMAXP && WS_CMAXP + 2 * (size_t)D * 4 <= 1024 * 1024, "control region map");

constexpr int CW_BAR = 4096, CW_QUEUE = 2048, CW_FLAG = 8192;
constexpr size_t WS_SS = 1 * MiB;
static_assert(WS_SS + 7 * (size_t)M * 8 <= CTL_ZERO_BYTES, "SS inside the memset region");
constexpr int LDSCTL_OFF = 144384, MISC_OFF = LDSCTL_OFF + 320;
constexpr int LDS_BYTES = 147456;

#define GAS __attribute__((address_space(1)))
#define LAS __attribute__((address_space(3)))
typedef unsigned short bf16;
typedef unsigned v4u __attribute__((ext_vector_type(4)));
typedef unsigned v2u __attribute__((ext_vector_type(2)));
typedef float f32x4 __attribute__((ext_vector_type(4)));
typedef short bf16x8 __attribute__((ext_vector_type(8)));
#define LDS_WAIT() asm volatile("s_waitcnt lgkmcnt(0)" ::: "memory")
#define WG_BARRIER() do { asm volatile("s_waitcnt lgkmcnt(0)" ::: "memory"); __builtin_amdgcn_s_barrier(); asm volatile("" ::: "memory"); } while (0)
__device__ __forceinline__ unsigned pk2(float lo, float hi) { return pg8::cvt_pk_bf16(lo, hi); }
__device__ __forceinline__ float bf_lo(unsigned w) { return __uint_as_float(w << 16); }
__device__ __forceinline__ float bf_hi(unsigned w) { return __uint_as_float(w & 0xffff0000u); }
#define MFMA16(a, b, c) __builtin_amdgcn_mfma_f32_16x16x32_bf16((a), (b), (c), 0, 0, 0)

#define XB_TMO      128
#define XB_XCNT(j)  (256  + 64 * (j))
#define XB_XSUB(j)  (1280 + 64 * (j))
#define XB_XGEN(j)  (2304 + 64 * (j))
#define XB_TOP      3328
#define XB_TOPGEN   3392
#define XCD_BAR_WORDS 3456
#define XB_SPIN_CAP (1u << 18)

__device__ __forceinline__ unsigned xb_ld(unsigned* p)              { return __hip_atomic_load(p, __ATOMIC_RELAXED, __HIP_MEMORY_SCOPE_AGENT); }
__device__ __forceinline__ unsigned xb_add(unsigned* p, unsigned v) { return __hip_atomic_fetch_add(p, v, __ATOMIC_RELAXED, __HIP_MEMORY_SCOPE_AGENT); }
__device__ __forceinline__ unsigned xb_xcc_id() { return (unsigned)__builtin_amdgcn_s_getreg((3 << 11) | 20) & 0xFu; }
#define XB_SPIN(cond, bar) do { unsigned _sp = 0; while (cond) { __builtin_amdgcn_s_sleep(1); \
    if ((++_sp & 255u) == 0u) { if (xb_ld(&(bar)[XB_TMO])) break; if (_sp > XB_SPIN_CAP) { atomicAdd(&(bar)[XB_TMO], 1u); break; } } } } while (0)

struct XcdBarrier { unsigned* bar; unsigned x; volatile LAS unsigned* st; };

__device__ __forceinline__ XcdBarrier xcd_barrier_post(unsigned* bar, volatile LAS unsigned* st) {
    XcdBarrier b; b.bar = bar; b.x = xb_xcc_id(); b.st = st;
    if (threadIdx.x == 0) (void)xb_add(&bar[XB_XCNT(b.x)], 1u);
    return b;
}
__device__ __forceinline__ void xcd_barrier_complete(unsigned* bar, unsigned x, unsigned& nloc, unsigned& nx) {
    const unsigned G = gridDim.x * gridDim.y * gridDim.z;
    unsigned sum, cnt, mine, sp = 0u;
    for (;;) {
        sum = 0u; cnt = 0u; mine = 0u;
#pragma unroll
        for (unsigned j = 0; j < 16; ++j) { const unsigned c = xb_ld(&bar[XB_XCNT(j)]); sum += c; cnt += (c > 0u) ? 1u : 0u; mine = (j == x) ? c : mine; }
        if (sum == G) break;
        __builtin_amdgcn_s_sleep(1);
        if ((++sp & 255u) == 0u) { if (xb_ld(&bar[XB_TMO])) break; if (sp > XB_SPIN_CAP) { atomicAdd(&bar[XB_TMO], 1u); break; } }
    }
    nloc = mine > 0u ? mine : 1u; nx = cnt > 0u ? cnt : 1u;
}
__device__ __forceinline__ void xcd_barrier(const XcdBarrier& b) {
    asm volatile("s_waitcnt vmcnt(0)" ::: "memory");
    __syncthreads();
    if (threadIdx.x == 0) {
        unsigned* bar = b.bar;
        __builtin_amdgcn_s_waitcnt(0);
        unsigned nloc = b.st[0], nx = b.st[1];
        if (nloc == 0u) { xcd_barrier_complete(bar, b.x, nloc, nx); b.st[0] = nloc; b.st[1] = nx; }
        const unsigned old = xb_add(&bar[XB_XSUB(b.x)], 1u);
        const unsigned gen = old / nloc;
        if (old + 1u == (gen + 1u) * nloc) {
            __builtin_amdgcn_fence(__ATOMIC_RELEASE, "agent");
            asm volatile("s_waitcnt vmcnt(0)" ::: "memory");
            const unsigned og = xb_add(&bar[XB_TOP], 1u);
            const unsigned tg = og / nx;
            if (og + 1u == (tg + 1u) * nx) xb_add(&bar[XB_TOPGEN], 1u);
            else XB_SPIN(xb_ld(&bar[XB_TOPGEN]) == tg, bar);
            __builtin_amdgcn_fence(__ATOMIC_ACQUIRE, "agent");
            xb_add(&bar[XB_XGEN(b.x)], 1u);
            asm volatile("s_waitcnt vmcnt(0)" ::: "memory");
        } else {
            XB_SPIN(xb_ld(&bar[XB_XGEN(b.x)]) == gen, bar);
            __builtin_amdgcn_fence(__ATOMIC_ACQUIRE, "agent");
            asm volatile("s_waitcnt vmcnt(0)" ::: "memory");
        }
    }
    __syncthreads();
}

#define DPP_ROR(v, ctrl) __builtin_bit_cast(float, __builtin_amdgcn_update_dpp(0, __builtin_bit_cast(int, (v)), (ctrl), 0xf, 0xf, false))
__device__ __forceinline__ float row16_sum_f(float v) { v += DPP_ROR(v, 0x128); v += DPP_ROR(v, 0x124); v += DPP_ROR(v, 0x122); v += DPP_ROR(v, 0x121); return v; }
__device__ __forceinline__ float row16_max_f(float v) { v = fmaxf(v, DPP_ROR(v, 0x128)); v = fmaxf(v, DPP_ROR(v, 0x124)); v = fmaxf(v, DPP_ROR(v, 0x122)); v = fmaxf(v, DPP_ROR(v, 0x121)); return v; }
__device__ __forceinline__ float wave_sum(float v) {
#pragma unroll
    for (int o = 1; o < 64; o <<= 1) v += __shfl_xor(v, o);
    return v;
}
constexpr int TR_SCR = 64 * 65 * 4 + 256;
__device__ __forceinline__ void transpose_item(const float* W, int K, int N, bf16* WT, size_t trow0, int k0, int n0, float sc, const float* gk, LAS float* scr, int lane) {
    f32x4 v[16];
    { const float* src = W + (size_t)(k0 + (lane >> 4)) * N + n0 + 4 * (lane & 15);
#pragma unroll
      for (int i = 0; i < 16; ++i) v[i] = __builtin_nontemporal_load((const GAS f32x4*)(src + (size_t)(4 * i) * N)); }
    const int c = lane & 7;
    f32x4 ga = (f32x4){1.f, 1.f, 1.f, 1.f}, gb = ga;
    if (gk) { ga = *(const GAS f32x4*)(gk + k0 + 8 * c); gb = *(const GAS f32x4*)(gk + k0 + 8 * c + 4); }
    { LAS float* d = scr + (lane >> 4) * 65 + 4 * (lane & 15);
#pragma unroll
      for (int i = 0; i < 16; ++i) { d[(4 * i) * 65 + 0] = v[i].x; d[(4 * i) * 65 + 1] = v[i].y; d[(4 * i) * 65 + 2] = v[i].z; d[(4 * i) * 65 + 3] = v[i].w; } }
    LDS_WAIT(); asm volatile("" ::: "memory");
    float g8[8];
#pragma unroll
    for (int q = 0; q < 8; ++q) g8[q] = gk ? (q < 4 ? ga[q] : gb[q - 4]) * sc : sc;
#pragma unroll
    for (int j = 0; j < 8; ++j) { const int n = (lane >> 3) + 8 * j; const LAS float* s = scr + (8 * c) * 65 + n;
        v4u o; o.x = pk2(s[0 * 65] * g8[0], s[1 * 65] * g8[1]); o.y = pk2(s[2 * 65] * g8[2], s[3 * 65] * g8[3]); o.z = pk2(s[4 * 65] * g8[4], s[5 * 65] * g8[5]); o.w = pk2(s[6 * 65] * g8[6], s[7 * 65] * g8[7]);
        *(GAS v4u*)(WT + (trow0 + n) * (size_t)K + k0 + 8 * c) = o; }
    LDS_WAIT(); asm volatile("" ::: "memory");
}
__device__ __forceinline__ void colmax_item(const float* W, int N, const float* gk, int k0, int n0, unsigned* cmax, int lane) {
    const float* src = W + (size_t)(k0 + (lane >> 4)) * N + n0 + 4 * (lane & 15);
    f32x4 mx = (f32x4){0.f, 0.f, 0.f, 0.f};
#pragma unroll
    for (int i = 0; i < 16; ++i) { const f32x4 v = __builtin_nontemporal_load((const GAS f32x4*)(src + (size_t)(4 * i) * N)); const float g = gk[k0 + (lane >> 4) + 4 * i];
        mx.x = fmaxf(mx.x, fabsf(v.x * g)); mx.y = fmaxf(mx.y, fabsf(v.y * g)); mx.z = fmaxf(mx.z, fabsf(v.z * g)); mx.w = fmaxf(mx.w, fabsf(v.w * g)); }
#pragma unroll
    for (int o = 16; o < 64; o <<= 1) { mx.x = fmaxf(mx.x, __shfl_xor(mx.x, o)); mx.y = fmaxf(mx.y, __shfl_xor(mx.y, o)); mx.z = fmaxf(mx.z, __shfl_xor(mx.z, o)); mx.w = fmaxf(mx.w, __shfl_xor(mx.w, o)); }
    if (lane < 16) { unsigned* c = cmax + n0 + 4 * lane; atomicMax(c, __float_as_uint(mx.x)); atomicMax(c + 1, __float_as_uint(mx.y)); atomicMax(c + 2, __float_as_uint(mx.z)); atomicMax(c + 3, __float_as_uint(mx.w)); }
}
__device__ __forceinline__ void colmax_wide(const float* W, int N, const float* gk, int k0, int n0, unsigned* cmax, int lane) {
    const float* src = W + (size_t)k0 * N + n0 + 4 * lane;
    f32x4 mx = (f32x4){0.f, 0.f, 0.f, 0.f};
#pragma unroll
    for (int b = 0; b < 4; ++b) { f32x4 v[16];
#pragma unroll
        for (int i = 0; i < 16; ++i) v[i] = __builtin_nontemporal_load((const GAS f32x4*)(src + (size_t)(16 * b + i) * N));
#pragma unroll
        for (int i = 0; i < 16; ++i) { const float g = gk[k0 + 16 * b + i];
            mx.x = fmaxf(mx.x, fabsf(v[i].x * g)); mx.y = fmaxf(mx.y, fabsf(v[i].y * g)); mx.z = fmaxf(mx.z, fabsf(v[i].z * g)); mx.w = fmaxf(mx.w, fabsf(v[i].w * g)); } }
    unsigned* c = cmax + n0 + 4 * lane; atomicMax(c, __float_as_uint(mx.x)); atomicMax(c + 1, __float_as_uint(mx.y)); atomicMax(c + 2, __float_as_uint(mx.z)); atomicMax(c + 3, __float_as_uint(mx.w));
}
__device__ __forceinline__ void transpose_item_q(const float* W, int K, int N, signed char* WQ, size_t trow0, int k0, int n0, const float* gk, const unsigned* cmax, float* DB, LAS float* scr, int lane) {
    f32x4 v[16];
    const int c = lane & 7;
    { const float* src = W + (size_t)(k0 + (lane >> 4)) * N + n0 + 4 * (lane & 15);
#pragma unroll
      for (int i = 0; i < 16; ++i) v[i] = __builtin_nontemporal_load((const GAS f32x4*)(src + (size_t)(4 * i) * N)); }
    const f32x4 ga = *(const GAS f32x4*)(gk + k0 + 8 * c), gb = *(const GAS f32x4*)(gk + k0 + 8 * c + 4);
    float cmv[8];
#pragma unroll
    for (int j = 0; j < 8; ++j) cmv[j] = __uint_as_float(*(const GAS unsigned*)(cmax + n0 + (lane >> 3) + 8 * j));
    { LAS float* d = scr + (lane >> 4) * 65 + 4 * (lane & 15);
#pragma unroll
      for (int i = 0; i < 16; ++i) { d[(4 * i) * 65 + 0] = v[i].x; d[(4 * i) * 65 + 1] = v[i].y; d[(4 * i) * 65 + 2] = v[i].z; d[(4 * i) * 65 + 3] = v[i].w; } }
    LDS_WAIT(); asm volatile("" ::: "memory");
    const float g8[8] = {ga.x, ga.y, ga.z, ga.w, gb.x, gb.y, gb.z, gb.w};
#pragma unroll
    for (int j = 0; j < 8; ++j) { const int n = (lane >> 3) + 8 * j; const LAS float* s = scr + (8 * c) * 65 + n;
        const float cm = cmv[j]; const float inv = cm > 0.f ? 127.0f * __builtin_amdgcn_rcpf(cm) : 0.f;
        int q8[8];
#pragma unroll
        for (int q = 0; q < 8; ++q) q8[q] = (int)rintf(s[q * 65] * g8[q] * inv);
        v2u o; o.x = (unsigned)(q8[0] & 255) | ((unsigned)(q8[1] & 255) << 8) | ((unsigned)(q8[2] & 255) << 16) | ((unsigned)(q8[3] & 255) << 24);
        o.y = (unsigned)(q8[4] & 255) | ((unsigned)(q8[5] & 255) << 8) | ((unsigned)(q8[6] & 255) << 16) | ((unsigned)(q8[7] & 255) << 24);
        *(GAS v2u*)(WQ + (trow0 + n) * (size_t)K + k0 + 8 * c) = o;
        if (k0 == 0 && c == 0) DB[trow0 + n] = cm * (1.0f / 127.0f); }
    LDS_WAIT(); asm volatile("" ::: "memory");
}
struct QRow { v4u x[8]; };
__device__ __forceinline__ void quant_load(QRow& r, const bf16* xrow, int lane) {
    const GAS v4u* xr = (const GAS v4u*)xrow + lane;
#pragma unroll
    for (int j = 0; j < 8; ++j) r.x[j] = xr[64 * j];
}
__device__ __forceinline__ void quant_finish(const QRow& r, signed char* qrow, float* ra, int lane) {
    GAS v2u* qr = (GAS v2u*)qrow + lane;
    float rm = 0.f, ss = 0.f;
#pragma unroll
    for (int j = 0; j < 8; ++j)
#pragma unroll
        for (int q = 0; q < 4; ++q) { const float a = bf_lo(r.x[j][q]), b = bf_hi(r.x[j][q]); rm = fmaxf(rm, fmaxf(fabsf(a), fabsf(b))); ss += a * a + b * b; }
    rm = row16_max_f(rm); ss = row16_sum_f(ss);
    { const float r1 = __shfl_xor(rm, 16), s1 = __shfl_xor(ss, 16); rm = fmaxf(rm, r1); ss += s1; }
    { const float r1 = __shfl_xor(rm, 32), s1 = __shfl_xor(ss, 32); rm = fmaxf(rm, r1); ss += s1; }
    const float inv = rm > 0.f ? 127.0f * __builtin_amdgcn_rcpf(rm) : 0.f;
#pragma unroll
    for (int j = 0; j < 8; ++j) { int q8[8];
#pragma unroll
        for (int q = 0; q < 4; ++q) { q8[2 * q] = (int)rintf(bf_lo(r.x[j][q]) * inv); q8[2 * q + 1] = (int)rintf(bf_hi(r.x[j][q]) * inv); }
        v2u o; o.x = (unsigned)(q8[0] & 255) | ((unsigned)(q8[1] & 255) << 8) | ((unsigned)(q8[2] & 255) << 16) | ((unsigned)(q8[3] & 255) << 24);
        o.y = (unsigned)(q8[4] & 255) | ((unsigned)(q8[5] & 255) << 8) | ((unsigned)(q8[6] & 255) << 16) | ((unsigned)(q8[7] & 255) << 24);
        qr[64 * j] = o; }
    if (lane == 0) *ra = __builtin_amdgcn_rsqf(ss * (1.0f / 4096.0f) + 1e-6f) * rm * (1.0f / 127.0f);
}
__device__ __forceinline__ void quant_pass(const bf16* X, signed char* XQ, float* RA, int first, int step, int lane) {
    QRow A, B; int m = first;
    if (m < M) quant_load(A, X + (size_t)m * D, lane);
    _Pragma("nounroll") for (; m < M; m += 2 * step) {
        const int m1 = m + step, m2 = m + 2 * step;
        if (m1 < M) quant_load(B, X + (size_t)m1 * D, lane);
        quant_finish(A, XQ + (size_t)m * D, RA + m, lane);
        if (m2 < M) quant_load(A, X + (size_t)m2 * D, lane);
        if (m1 < M) quant_finish(B, XQ + (size_t)m1 * D, RA + m1, lane);
    }
}
constexpr int CV_IN = (D / 64) * (NIN / 64), CV_PP = (PLE / 64) * (D / 64), CV_A = CV_IN + CV_PP;
constexpr int CV_OUT = (D / 64) * (D / 64), CV_G = (D / 64) * (DFF / 64), CV_DN = (DFF / 64) * (D / 64), CV_ALL = CV_A + CV_OUT + 2 * CV_G + CV_DN + CV_OUT;
struct CvPtrs { const float *w_in, *w_pp, *w_out, *w_gate, *w_up, *w_down, *w_pg, *g_mix, *g_ffn, *g_ple; bf16 *WinT, *WppT, *WoutT, *WguT, *WdnT, *WpgT; const unsigned* cmax; float* DB; const unsigned* cmaxp; float* DBP; signed char* WinQ; const unsigned* cmaxi; float* DBI; };
__device__ __forceinline__ void convert_item(const CvPtrs& P, int it, LAS float* scr, int lane) {
    int r = it;
    if (r < CV_IN) { const int nblk = NIN / 64, kb = r / nblk, n0 = 64 * (r % nblk); const float sc = (n0 >= COL_RK && n0 < COL_RV) ? 0.08838834764831845f : 1.0f;
        const bool isv = n0 < COL_RK || (n0 >= COL_RV && n0 < COL_RG) || n0 >= COL_AV;
        if (isv) transpose_item_q(P.w_in, D, NIN, P.WinQ, (size_t)(n0 < COL_RK ? n0 : (n0 < COL_RG ? n0 - COL_RV + 2048 : n0 - COL_AV + 4096)), 64 * kb, n0, P.g_mix, P.cmaxi, P.DBI, scr, lane);
        else transpose_item(P.w_in, D, NIN, P.WinT, (size_t)(n0 < COL_RV ? n0 - COL_RK : n0 - 4096), 64 * kb, n0, sc, P.g_mix, scr, lane);
        return; } r -= CV_IN;
    if (r < CV_PP) { const int nblk = D / 64, kb = r / nblk, n0 = 64 * (r % nblk); transpose_item(P.w_pp, PLE, D, P.WppT, (size_t)n0, 64 * kb, n0, 1.0f, nullptr, scr, lane); return; } r -= CV_PP;
    if (r < CV_OUT) { const int nblk = D / 64, kb = r / nblk, n0 = 64 * (r % nblk); transpose_item(P.w_out, D, D, P.WoutT, (size_t)n0, 64 * kb, n0, 1.0f, nullptr, scr, lane); return; } r -= CV_OUT;
    if (r < CV_G) { const int nblk = DFF / 64, kb = r / nblk, n0 = 64 * (r % nblk); transpose_item_q(P.w_gate, D, DFF, (signed char*)P.WguT, (size_t)((n0 >> 7) * 256 + (n0 & 127)), 64 * kb, n0, P.g_ffn, P.cmax, P.DB, scr, lane); return; } r -= CV_G;
    if (r < CV_G) { const int nblk = DFF / 64, kb = r / nblk, n0 = 64 * (r % nblk); transpose_item_q(P.w_up, D, DFF, (signed char*)P.WguT, (size_t)((n0 >> 7) * 256 + 128 + (n0 & 127)), 64 * kb, n0, P.g_ffn, P.cmax + DFF, P.DB, scr, lane); return; } r -= CV_G;
    if (r < CV_DN) { const int nblk = D / 64, kb = r / nblk, n0 = 64 * (r % nblk); transpose_item(P.w_down, DFF, D, P.WdnT, (size_t)n0, 64 * kb, n0, 1.0f, nullptr, scr, lane); return; } r -= CV_DN;
    { const int nblk = D / 64, kb = r / nblk, n0 = 64 * (r % nblk); transpose_item_q(P.w_pg, D, D, (signed char*)P.WpgT, (size_t)n0, 64 * kb, n0, P.g_ple, P.cmaxp, P.DBP, scr, lane); }
}
#define CV_PTRS(P, ka, ws, layer) CvPtrs P; P.w_in = ka->in[5] + (size_t)(layer) * D * NIN; P.w_pp = ka->in[17] + (size_t)(layer) * PLE * D; P.w_out = ka->in[10] + (size_t)(layer) * D * D; \
    P.w_gate = ka->in[12] + (size_t)(layer) * D * DFF; P.w_up = ka->in[13] + (size_t)(layer) * D * DFF; P.w_down = ka->in[14] + (size_t)(layer) * DFF * D; P.w_pg = ka->in[16] + (size_t)(layer) * D * D; \
    P.g_mix = ka->in[4] + (size_t)(layer) * D; P.g_ffn = ka->in[11] + (size_t)(layer) * D; P.g_ple = ka->in[15] + (size_t)(layer) * D; \
    P.WinT = (bf16*)(ws + WS_WIN); P.WppT = (bf16*)(ws + WS_WPP); P.WoutT = (bf16*)(ws + WS_WOUT); P.WguT = (bf16*)(ws + WS_WGU); P.WdnT = (bf16*)(ws + WS_WDN); P.WpgT = (bf16*)(ws + WS_WPG); \
    P.cmax = (const unsigned*)(ws + WS_CMAX) + (size_t)(layer) * NGU; P.DB = (float*)(ws + WS_DB); P.cmaxp = (const unsigned*)(ws + WS_CMAXP) + (size_t)(layer) * D; P.DBP = (float*)(ws + WS_DBP); \
    P.WinQ = (signed char*)(ws + WS_WINQ); P.cmaxi = (const unsigned*)(ws + WS_CMAXI) + (size_t)(layer) * NIN; P.DBI = (float*)(ws + WS_DBI)

__device__ __forceinline__ void x_row_in(const float* xrow, bf16* orow, pg8::u64_t* ss, signed char* qrow, float* ra, int lane) {
    const GAS f32x4* xr = (const GAS f32x4*)xrow + lane;
    f32x4 v[16];
#pragma unroll
    for (int j = 0; j < 16; ++j) v[j] = __builtin_nontemporal_load(xr + 64 * j);
    GAS v2u* o8 = (GAS v2u*)orow + lane; float s = 0.f, mx = 0.f;
#pragma unroll
    for (int j = 0; j < 16; ++j) { v2u o; o.x = pk2(v[j].x, v[j].y); o.y = pk2(v[j].z, v[j].w); o8[64 * j] = o;
        const float a = bf_lo(o.x), b = bf_hi(o.x), c = bf_lo(o.y), d = bf_hi(o.y); s += (a * a + b * b) + (c * c + d * d); v[j] = (f32x4){a, b, c, d};
        mx = fmaxf(mx, fmaxf(fmaxf(fabsf(a), fabsf(b)), fmaxf(fabsf(c), fabsf(d)))); }
    s = row16_sum_f(s); mx = row16_max_f(mx);
    { const float m1 = __shfl_xor(mx, 16), s1 = __shfl_xor(s, 16); mx = fmaxf(mx, m1); s += s1; }
    { const float m1 = __shfl_xor(mx, 32), s1 = __shfl_xor(s, 32); mx = fmaxf(mx, m1); s += s1; }
    const pg8::u64_t sf = pg8::ss_fix(s); const float inv = mx > 0.f ? 127.0f * __builtin_amdgcn_rcpf(mx) : 0.f;
    GAS unsigned* q4 = (GAS unsigned*)qrow + lane;
#pragma unroll
    for (int j = 0; j < 16; ++j) { const int q0 = (int)rintf(v[j].x * inv), q1 = (int)rintf(v[j].y * inv), q2 = (int)rintf(v[j].z * inv), q3 = (int)rintf(v[j].w * inv);
        q4[64 * j] = (unsigned)(q0 & 255) | ((unsigned)(q1 & 255) << 8) | ((unsigned)(q2 & 255) << 16) | ((unsigned)(q3 & 255) << 24); }
    if (lane == 0) { *ss = sf; *ra = pg8::ss_rs(sf) * mx * (1.0f / 127.0f); }
}

__device__ __forceinline__ float fast_rsqrt(float x) { return __builtin_amdgcn_rsqf(x); }
__device__ __forceinline__ float row16_sum(float v) {
    v += __builtin_bit_cast(float, __builtin_amdgcn_update_dpp(0, __builtin_bit_cast(int, v), 0x128, 0xf, 0xf, false));
    v += __builtin_bit_cast(float, __builtin_amdgcn_update_dpp(0, __builtin_bit_cast(int, v), 0x124, 0xf, 0xf, false));
    v += __builtin_bit_cast(float, __builtin_amdgcn_update_dpp(0, __builtin_bit_cast(int, v), 0x122, 0xf, 0xf, false));
    v += __builtin_bit_cast(float, __builtin_amdgcn_update_dpp(0, __builtin_bit_cast(int, v), 0x121, 0xf, 0xf, false));
    return v;
}
constexpr int RS = 272;
constexpr int RSB = 288;
constexpr int R_K = 0, R_KW = 128 * RS, R_V = R_KW + 128 * RSB, R_ST = R_V + 128 * RSB;
constexpr int R_GN = R_ST + 128 * RS;
static_assert(R_GN + 512 <= LDSCTL_OFF, "retention LDS");
typedef short s16x4 __attribute__((ext_vector_type(4)));
__device__ __forceinline__ s16x4 ds_tr(LAS unsigned char* p) { return __builtin_bit_cast(s16x4, __builtin_amdgcn_ds_read_tr16_b64_v4i16((LAS s16x4*)p)); }
__device__ __forceinline__ bf16x8 ds_tr2(LAS unsigned char* p, int rstride) { const s16x4 a = ds_tr(p), b = ds_tr(p + 16 * rstride); bf16x8 r; r[0] = a[0]; r[1] = a[1]; r[2] = a[2]; r[3] = a[3]; r[4] = b[0]; r[5] = b[1]; r[6] = b[2]; r[7] = b[3]; return r; }
__device__ __forceinline__ v4u scale8(v4u x, float sc) { v4u o; o.x = pk2(bf_lo(x.x) * sc, bf_hi(x.x) * sc); o.y = pk2(bf_lo(x.y) * sc, bf_hi(x.y) * sc); o.z = pk2(bf_lo(x.z) * sc, bf_hi(x.z) * sc); o.w = pk2(bf_lo(x.w) * sc, bf_hi(x.w) * sc); return o; }

__device__ __forceinline__ void seq_info(int seq, int& rowbase, int& L) { if (seq < 2) { rowbase = seq * 4096; L = 4096; } else { rowbase = 8192 + (seq - 2) * 2048; L = 2048; } }
__device__ __forceinline__ const bf16* zplane(const bf16* ZH, int sec, int h) { return ZH + (size_t)(sec * NH + h) * M * HD; }

#define RLX_AGENT __ATOMIC_RELAXED, __HIP_MEMORY_SCOPE_AGENT
template <int DIR, bool INTRA, bool FINAL> __device__ __forceinline__ void retention_pass(LAS unsigned char* lds, const bf16* ZH, bf16* YF, bf16* MIX, const float* ld, const float* gn, int seq, int h, int n0, int ncnt,
                                                                                          const unsigned long long* imp, unsigned* impflag, unsigned long long* expo, unsigned* expflag, int tid0) {
    int rowbase, L; seq_info(seq, rowbase, L);
    const bf16* Qp = zplane(ZH, 0, h) + (size_t)rowbase * HD; const bf16* Kp = zplane(ZH, 1, h) + (size_t)rowbase * HD;
    const bf16* Vp = zplane(ZH, 2, h) + (size_t)rowbase * HD; const bf16* Gp = zplane(ZH, 3, h) + (size_t)rowbase * HD;
    const float lf0 = ld[h], lb0 = ld[NH + h];
    f32x4 st[8];
    {
        const float gC = __expf((DIR == 0 ? lf0 : lb0) * 128.f);
        v4u kreg[4], vreg[4]; bf16x8 qf[4];
        { const int n = DIR == 0 ? n0 : n0 + ncnt - 1; const int srow = tid0 >> 4, sch = tid0 & 15, w = tid0 >> 6, lr = tid0 & 15, lg = (tid0 >> 4) & 3;
#pragma unroll
          for (int cc = 0; cc < 4; ++cc) { kreg[cc] = *(const GAS v4u*)(Kp + (size_t)(n * 128 + srow + 32 * cc) * HD + 8 * sch); vreg[cc] = *(const GAS v4u*)(Vp + (size_t)(n * 128 + srow + 32 * cc) * HD + 8 * sch); }
#pragma unroll
          for (int ks = 0; ks < 4; ++ks) qf[ks] = *(const GAS bf16x8*)(Qp + (size_t)(n * 128 + 16 * w + lr) * HD + 8 * lg + 32 * ks); }
        if (imp) {
            if (tid0 == 0) { unsigned spins = 0; while (__hip_atomic_load(impflag, RLX_AGENT) == 0u && ++spins < (1u << 22)) __builtin_amdgcn_s_sleep(2); }
            __syncthreads();
#pragma unroll
            for (int e = 0; e < 8; ++e) { const unsigned long long a = __hip_atomic_load(imp + (size_t)(e * 512 + tid0) * 2, RLX_AGENT), b = __hip_atomic_load(imp + (size_t)(e * 512 + tid0) * 2 + 1, RLX_AGENT);
                st[e][0] = __uint_as_float((unsigned)a); st[e][1] = __uint_as_float((unsigned)(a >> 32)); st[e][2] = __uint_as_float((unsigned)b); st[e][3] = __uint_as_float((unsigned)(b >> 32)); }
        } else {
#pragma unroll
            for (int e = 0; e < 8; ++e) st[e] = (f32x4){0.f, 0.f, 0.f, 0.f};
        }
        if constexpr (FINAL) {
            if (tid0 < 32) *(LAS f32x4*)(lds + R_GN + 16 * tid0) = *(const GAS f32x4*)(gn + h * HD + 4 * tid0);
        }
        for (int cn = 0; cn < ncnt; ++cn) {
            const int n = DIR == 0 ? n0 + cn : n0 + ncnt - 1 - cn, nn = DIR == 0 ? n + 1 : n - 1;
            const int r0 = rowbase + n * 128;
            int tid = tid0; float lf = lf0, lb = lb0; asm volatile("" : "+v"(tid), "+v"(lf), "+v"(lb));
            const int w = tid >> 6, l = tid & 63, lr = l & 15, lg = l >> 4, srow = tid >> 4, sch = tid & 15;
            LAS unsigned char* trp = lds + (4 * lg + ((l & 15) >> 2)) * RSB + (l & 3) * 8;
            WG_BARRIER();
#pragma unroll
            for (int cc = 0; cc < 4; ++cc) { const int row = srow + 32 * cc;
                if constexpr (INTRA) *(LAS v4u*)(lds + R_K + row * RS + 16 * sch) = kreg[cc];
                const float wj = DIR == 0 ? __expf(lf * (float)(127 - row)) : __expf(lb * (float)row);
                *(LAS v4u*)(lds + R_KW + row * RSB + 16 * sch) = scale8(kreg[cc], wj);
                *(LAS v4u*)(lds + R_V + row * RSB + 16 * sch) = vreg[cc]; }
#pragma unroll
            for (int e = 0; e < 8; ++e) { v2u o; o.x = pk2(st[e][0], st[e][1]); o.y = pk2(st[e][2], st[e][3]); *(LAS v2u*)(lds + R_ST + (16 * e + lr) * RS + (16 * w + 4 * lg) * 2) = o; }
            WG_BARRIER();
            bf16x8 qx[4];
            { const float xi = DIR == 0 ? __expf(lf * (float)(16 * w + lr + 1)) : __expf(lb * (float)(128 - 16 * w - lr));
#pragma unroll
              for (int ks = 0; ks < 4; ++ks) qx[ks] = __builtin_bit_cast(bf16x8, scale8(__builtin_bit_cast(v4u, qf[ks]), xi)); }
            bf16x8 pt[4];
            if constexpr (INTRA) {
                f32x4 s[8];
#pragma unroll
                for (int jt = 0; jt < 8; ++jt) { s[jt] = (f32x4){0.f, 0.f, 0.f, 0.f};
#pragma unroll
                    for (int ks = 0; ks < 4; ++ks) { const bf16x8 a = *(const LAS bf16x8*)(lds + R_K + (16 * jt + lr) * RS + (8 * lg + 32 * ks) * 2); s[jt] = MFMA16(a, qf[ks], s[jt]); }
                    __builtin_amdgcn_sched_barrier(0); }
                float Fr[4], Br[4];
#pragma unroll
                for (int r = 0; r < 4; ++r) { const float br = (float)(lr - 4 * lg - r); Fr[r] = __expf(lf * br); Br[r] = __expf(-lb * br); }
#pragma unroll
                for (int jt = 0; jt < 8; ++jt) { const int dt = w - jt; const float cf = __expf(lf * 16.f * (float)dt), cb = __expf(-lb * 16.f * (float)dt);
#pragma unroll
                    for (int r = 0; r < 4; ++r) { const float dec = dt > 0 ? Fr[r] * cf : (dt < 0 ? Br[r] * cb : ((lr - 4 * lg - r) >= 0 ? Fr[r] : Br[r])); s[jt][r] *= dec; } }
#pragma unroll
                for (int ks = 0; ks < 4; ++ks) { v4u o; o.x = pk2(s[2 * ks][0], s[2 * ks][1]); o.y = pk2(s[2 * ks][2], s[2 * ks][3]); o.z = pk2(s[2 * ks + 1][0], s[2 * ks + 1][1]); o.w = pk2(s[2 * ks + 1][2], s[2 * ks + 1][3]); pt[ks] = __builtin_bit_cast(bf16x8, o); }
            }
            f32x4 y[8];
#pragma unroll
            for (int e = 0; e < 8; ++e) y[e] = (f32x4){0.f, 0.f, 0.f, 0.f};
            { bf16x8 kwf[4];
#pragma unroll
              for (int ks = 0; ks < 4; ++ks) kwf[ks] = ds_tr2(trp + R_KW + (32 * ks) * RSB + (16 * w) * 2, RSB);
#pragma unroll
              for (int e = 0; e < 8; ++e) { st[e] = st[e] * gC;
#pragma unroll
                for (int ks = 0; ks < 4; ++ks) { const bf16x8 vf = ds_tr2(trp + R_V + (32 * ks) * RSB + (16 * e) * 2, RSB);
                    if constexpr (INTRA) y[e] = MFMA16(vf, pt[ks], y[e]);
                    st[e] = MFMA16(kwf[ks], vf, st[e]); }
                __builtin_amdgcn_sched_barrier(0); } }
            v2u ywv[8], gwv[8];
            if constexpr (FINAL) { const int row_ = r0 + 16 * w + lr; const bf16* yp_ = YF + (size_t)row_ * 2048 + h * HD + 4 * lg; const bf16* gp_ = Gp + (size_t)(n * 128 + 16 * w + lr) * HD + 4 * lg;
#pragma unroll
                for (int e = 0; e < 8; ++e) { ywv[e] = *(const GAS v2u*)(yp_ + 16 * e); gwv[e] = *(const GAS v2u*)(gp_ + 16 * e); } }
            if (cn + 1 < ncnt) {
#pragma unroll
              for (int cc = 0; cc < 4; ++cc) { kreg[cc] = *(const GAS v4u*)(Kp + (size_t)(nn * 128 + srow + 32 * cc) * HD + 8 * sch); vreg[cc] = *(const GAS v4u*)(Vp + (size_t)(nn * 128 + srow + 32 * cc) * HD + 8 * sch); }
#pragma unroll
              for (int ks = 0; ks < 4; ++ks) qf[ks] = *(const GAS bf16x8*)(Qp + (size_t)(nn * 128 + 16 * w + lr) * HD + 8 * lg + 32 * ks); }
#pragma unroll
            for (int e = 0; e < 8; ++e) {
#pragma unroll
                for (int ks = 0; ks < 4; ++ks) { const bf16x8 sf = *(const LAS bf16x8*)(lds + R_ST + (16 * e + lr) * RS + (8 * lg + 32 * ks) * 2); y[e] = MFMA16(sf, qx[ks], y[e]); }
                __builtin_amdgcn_sched_barrier(0); }
            const int row = r0 + 16 * w + lr;
            bf16* yp = YF + (size_t)row * 2048 + h * HD + 4 * lg;
            if constexpr (!FINAL) {
#pragma unroll
                for (int e = 0; e < 8; ++e) { v2u o; o.x = pk2(y[e][0], y[e][1]); o.y = pk2(y[e][2], y[e][3]); *(GAS v2u*)(yp + 16 * e) = o; }
            } else {
                float sum = 0.f;
#pragma unroll
                for (int e = 0; e < 8; ++e) { const v2u yw = ywv[e]; y[e][0] += bf_lo(yw.x); y[e][1] += bf_hi(yw.x); y[e][2] += bf_lo(yw.y); y[e][3] += bf_hi(yw.y); sum += (y[e][0] + y[e][1]) + (y[e][2] + y[e][3]); }
                sum += __shfl_xor(sum, 16); sum += __shfl_xor(sum, 32);
                const float mu = sum * (1.f / 128.f); float q = 0.f;
#pragma unroll
                for (int e = 0; e < 8; ++e) { y[e] = y[e] - mu; q += (y[e][0] * y[e][0] + y[e][1] * y[e][1]) + (y[e][2] * y[e][2] + y[e][3] * y[e][3]); }
                q += __shfl_xor(q, 16); q += __shfl_xor(q, 32);
                const float rstd = fast_rsqrt(q * (1.f / 128.f) + GN_EPS);
                bf16* mp = MIX + (size_t)row * D + h * HD + 4 * lg;
#pragma unroll
                for (int e = 0; e < 8; ++e) { const v2u gw2 = gwv[e]; const f32x4 gg = *(const LAS f32x4*)(lds + R_GN + (16 * e + 4 * lg) * 4);
                    const float g0 = bf_lo(gw2.x), g1 = bf_hi(gw2.x), g2 = bf_lo(gw2.y), g3 = bf_hi(gw2.y);
                    v2u o; o.x = pk2(g0 * pg8::fast_sigmoid(g0) * (y[e][0] * rstd * gg.x), g1 * pg8::fast_sigmoid(g1) * (y[e][1] * rstd * gg.y));
                    o.y = pk2(g2 * pg8::fast_sigmoid(g2) * (y[e][2] * rstd * gg.z), g3 * pg8::fast_sigmoid(g3) * (y[e][3] * rstd * gg.w));
                    *(GAS v2u*)(mp + 16 * e) = o; }
            }
        }
        if (expo) {
#pragma unroll
            for (int e = 0; e < 8; ++e) { __hip_atomic_store(expo + (size_t)(e * 512 + tid0) * 2, (unsigned long long)__float_as_uint(st[e][0]) | ((unsigned long long)__float_as_uint(st[e][1]) << 32), RLX_AGENT);
                __hip_atomic_store(expo + (size_t)(e * 512 + tid0) * 2 + 1, (unsigned long long)__float_as_uint(st[e][2]) | ((unsigned long long)__float_as_uint(st[e][3]) << 32), RLX_AGENT); }
            asm volatile("s_waitcnt vmcnt(0)" ::: "memory");
            __syncthreads();
            if (tid0 == 0) __hip_atomic_store(expflag, 1u, RLX_AGENT);
        }
        __syncthreads();
    }
}

__device__ __forceinline__ void retention_item(LAS unsigned char* lds, const bf16* ZH, bf16* YF, bf16* MIX, const float* ld, const float* gn, unsigned long long* EXP, unsigned* flags, int item, int tid0) {
    if (item < 64) {
        const int chain = item & 31, seq = chain >> 4, h = chain & 15;
        unsigned long long* slot_f = EXP + (size_t)(chain * 2 + 0) * 8192; unsigned long long* slot_b = EXP + (size_t)(chain * 2 + 1) * 8192;
        unsigned* flag_f = flags + 64 * (chain * 2 + 0); unsigned* flag_b = flags + 64 * (chain * 2 + 1);
        if (item < 32) { retention_pass<0, true, false>(lds, ZH, YF, MIX, ld, gn, seq, h, 0, 16, nullptr, nullptr, slot_f, flag_f, tid0);
                         retention_pass<1, false, true>(lds, ZH, YF, MIX, ld, gn, seq, h, 0, 16, slot_b, flag_b, nullptr, nullptr, tid0); }
        else           { retention_pass<1, false, false>(lds, ZH, YF, MIX, ld, gn, seq, h, 16, 16, nullptr, nullptr, slot_b, flag_b, tid0);
                         retention_pass<0, true, true>(lds, ZH, YF, MIX, ld, gn, seq, h, 16, 16, slot_f, flag_f, nullptr, nullptr, tid0); }
    } else {
        const int c = item - 64, seq = 2 + (c >> 4), h = c & 15;
        retention_pass<0, true, false>(lds, ZH, YF, MIX, ld, gn, seq, h, 0, 16, nullptr, nullptr, nullptr, nullptr, tid0);
        retention_pass<1, false, true>(lds, ZH, YF, MIX, ld, gn, seq, h, 0, 16, nullptr, nullptr, nullptr, nullptr, tid0);
    }
}

constexpr int A_K = 0, A_V = 256 * RS;
static_assert(A_V + 256 * RSB <= LDSCTL_OFF, "attention LDS");
struct AttBlk { int d, dsh, r, qi0, m, b; };
__device__ __forceinline__ AttBlk att_blk(int blk, int t0, int L) {
    AttBlk a;
    if (blk < 16) { a.dsh = 4; a.r = blk; a.b = 0; } else if (blk < 32) { a.dsh = 2; a.r = (blk - 16) >> 2; a.b = (blk - 16) & 3; } else { a.dsh = 0; a.r = 0; a.b = blk - 32; }
    a.d = 1 << a.dsh; a.m = L >> a.dsh; a.qi0 = (t0 >> a.dsh) + 128 * a.b; return a;
}
__device__ __forceinline__ void attention_item(LAS unsigned char* lds, const bf16* ZH, bf16* OP, float* LP, bf16* MIX, const float* qg, const float* kg, int item, int tid0) {
    const int s8 = item >> 4, h = item & 15;
    int seq, t0; if (s8 < 4) { seq = s8 >> 1; t0 = (s8 & 1) * 2048; } else { seq = s8 - 2; t0 = 0; }
    int rowbase, L; seq_info(seq, rowbase, L);
    const float slope = exp2f(-0.5f * (float)(h + 1));
    float smax;
    { const int l = tid0 & 63; float mq = fmaxf(fabsf(qg[l]), fabsf(qg[l + 64])), mk = fmaxf(fabsf(kg[l]), fabsf(kg[l + 64]));
#pragma unroll
      for (int o = 1; o < 64; o <<= 1) { mq = fmaxf(mq, __shfl_xor(mq, o)); mk = fmaxf(mk, __shfl_xor(mk, o)); }
      smax = mq * mk * 11.3137085f; }
    const bf16* Qp = zplane(ZH, 4, h) + (size_t)rowbase * HD; const bf16* Kp = zplane(ZH, 5, h) + (size_t)rowbase * HD; const bf16* Vp = zplane(ZH, 6, h) + (size_t)rowbase * HD;
    auto att_load = [&](v4u (&kq)[8], v4u (&vq)[8], int BLK) __attribute__((always_inline)) {
        const AttBlk nb_ = att_blk(BLK, t0, L); const int krow_ = tid0 >> 4, kc_ = tid0 & 15;
#pragma unroll
        for (int p = 0; p < 8; ++p) if (p >= 4 || nb_.b == 0) { const int kidx = nb_.qi0 - 64 + 32 * p + krow_; kq[p] = (v4u){0u, 0u, 0u, 0u}; vq[p] = (v4u){0u, 0u, 0u, 0u};
            if ((unsigned)kidx < (unsigned)nb_.m) { const unsigned ro = (unsigned)((nb_.r + nb_.d * kidx) * HD + 8 * kc_) * 2u; kq[p] = *(const GAS v4u*)((const GAS char*)Kp + ro); vq[p] = *(const GAS v4u*)((const GAS char*)Vp + ro); } }
    };
    auto att_load_q = [&](v4u (&qw)[4], int BLK) __attribute__((always_inline)) {
        const AttBlk nb_ = att_blk(BLK, t0, L); const int w_ = tid0 >> 6, lr_ = tid0 & 15, lg_ = (tid0 >> 4) & 3;
        const unsigned qo_ = (unsigned)((nb_.r + nb_.d * (nb_.qi0 + 16 * w_ + lr_)) * HD + 8 * lg_) * 2u;
#pragma unroll
        for (int ks = 0; ks < 4; ++ks) qw[ks] = *(const GAS v4u*)((const GAS char*)Qp + qo_ + 64 * ks);
    };
    auto att_body = [&](v4u (&kq)[8], v4u (&vq)[8], v4u (&qw)[4], int blk) __attribute__((always_inline)) {
        const AttBlk B = att_blk(blk, t0, L);
        if (blk == 32) __syncthreads();
        int tid = tid0; asm volatile("" : "+v"(tid));
        const int w = tid >> 6, l = tid & 63, lr = l & 15, lg = l >> 4, krow = tid >> 4, kc = tid & 15, jt0 = w & ~1;
        const int off = 128 * (B.b & 1);
        const float sd = slope * (float)B.d;
        bf16x8 qf[4];
#pragma unroll
        for (int ks = 0; ks < 4; ++ks) qf[ks] = __builtin_bit_cast(bf16x8, qw[ks]);
        WG_BARRIER();
#pragma unroll
        for (int p = 0; p < 8; ++p) if (p >= 4 || B.b == 0) { const int slot = (32 * p + krow + off) & 255;
            *(LAS v4u*)(lds + A_K + slot * RS + 16 * kc) = kq[p];
            *(LAS v4u*)(lds + A_V + slot * RSB + 16 * kc) = vq[p]; }
        WG_BARRIER();
        f32x4 sT[10];
#pragma unroll
        for (int t = 0; t < 10; ++t) sT[t] = (f32x4){0.f, 0.f, 0.f, 0.f};
#pragma unroll
        for (int ks = 0; ks < 4; ++ks) {
#pragma unroll
            for (int t = 0; t < 10; ++t) { const int rowb = (16 * (jt0 + t) + off) & 255;
                const bf16x8 a = *(const LAS bf16x8*)(lds + A_K + (rowb + lr) * RS + (8 * lg + 32 * ks) * 2); sT[t] = MFMA16(a, qf[ks], sT[t]);
                if (t == 4) __builtin_amdgcn_sched_barrier(0); }
            __builtin_amdgcn_sched_barrier(0); }
        if (blk + 1 < 48) att_load_q(qw, blk + 1);
        float lsum = 0.f;
        {
          const int i = 16 * w + lr, rb = 16 * jt0 + 4 * lg - 64 - i, lo_i = -(i + B.qi0), hi_i = B.m - 1 - i - B.qi0;
          const float rbf = (float)rb, LO = (float)(lo_i > -64 ? lo_i : -64), HI = (float)(hi_i < 64 ? hi_i : 64);
          const float L2E = 1.4426950408889634f, sdl = sd * L2E, sml = smax * L2E;
#pragma unroll
          for (int t = 0; t < 10; ++t)
#pragma unroll
            for (int rr = 0; rr < 4; ++rr) { const float relf = rbf + (float)(16 * t + rr);
                const float x = __builtin_fmaf(sT[t][rr], L2E, __builtin_fmaf(-sdl, __builtin_fabsf(relf), -sml));
                const bool ok = __builtin_amdgcn_fmed3f(relf, LO, HI) == relf;
                const float p = ok ? __builtin_amdgcn_exp2f(x) : 0.f; sT[t][rr] = p; lsum += p; } }
        bf16x8 pt[5];
#pragma unroll
        for (int k = 0; k < 5; ++k) { v4u o; o.x = pk2(sT[2 * k][0], sT[2 * k][1]); o.y = pk2(sT[2 * k][2], sT[2 * k][3]); o.z = pk2(sT[2 * k + 1][0], sT[2 * k + 1][1]); o.w = pk2(sT[2 * k + 1][2], sT[2 * k + 1][3]); pt[k] = __builtin_bit_cast(bf16x8, o); }
        f32x4 o[8];
        { LAS unsigned char* trp = lds + A_V + (4 * lg + ((l & 15) >> 2)) * RSB + (l & 3) * 8;
#pragma unroll
          for (int e = 0; e < 8; ++e) o[e] = (f32x4){0.f, 0.f, 0.f, 0.f};
#pragma unroll
          for (int k = 0; k < 5; ++k) { const int rowb = (16 * jt0 + 32 * k + off) & 255;
#pragma unroll
            for (int e = 0; e < 8; ++e) { const bf16x8 vf = ds_tr2(trp + rowb * RSB + (16 * e) * 2, RSB); o[e] = MFMA16(vf, pt[k], o[e]);
                if (e == 3) __builtin_amdgcn_sched_barrier(0); }
            __builtin_amdgcn_sched_barrier(0); } }
        lsum += __shfl_xor(lsum, 16); lsum += __shfl_xor(lsum, 32);
        const int row = rowbase + B.r + B.d * (B.qi0 + 16 * w + lr);
        if (B.dsh != 0) {
            const int pb = B.dsh == 4 ? 0 : 1;
            bf16* op = OP + ((size_t)pb * M + row) * 2048 + h * HD + 4 * lg;
#pragma unroll
            for (int e = 0; e < 8; ++e) { v2u ov; ov.x = pk2(o[e][0], o[e][1]); ov.y = pk2(o[e][2], o[e][3]); *(GAS v2u*)(op + 16 * e) = ov; }
            if (lg == 0) LP[((size_t)pb * NH + h) * M + row] = lsum;
        } else {
            const bf16* p0 = OP + ((size_t)0 * M + row) * 2048 + h * HD + 4 * lg; const bf16* p1 = OP + ((size_t)1 * M + row) * 2048 + h * HD + 4 * lg;
            v2u pa[8], pc[8];
#pragma unroll
            for (int e = 0; e < 8; ++e) { pa[e] = *(const GAS v2u*)(p0 + 16 * e); pc[e] = *(const GAS v2u*)(p1 + 16 * e); }
            const float inv = __builtin_amdgcn_rcpf(lsum + LP[((size_t)0 * NH + h) * M + row] + LP[((size_t)1 * NH + h) * M + row]);
            bf16* mp = MIX + (size_t)row * D + 2048 + h * HD + 4 * lg;
#pragma unroll
            for (int e = 0; e < 8; ++e) { const v2u a = pa[e], c = pc[e];
                v2u ov; ov.x = pk2((o[e][0] + bf_lo(a.x) + bf_lo(c.x)) * inv, (o[e][1] + bf_hi(a.x) + bf_hi(c.x)) * inv); ov.y = pk2((o[e][2] + bf_lo(a.y) + bf_lo(c.y)) * inv, (o[e][3] + bf_hi(a.y) + bf_hi(c.y)) * inv);
                *(GAS v2u*)(mp + 16 * e) = ov; }
        }
    };
    v4u kA[8], vA[8], kB[8], vB[8], qW[4];
    att_load(kA, vA, 0); att_load_q(qW, 0);
    _Pragma("nounroll") for (int blk = 0; blk < 48; blk += 2) {
        att_load(kB, vB, blk + 1);
        att_body(kA, vA, qW, blk);
        if (blk + 2 < 48) att_load(kA, vA, blk + 2);
        att_body(kB, vB, qW, blk + 1);
    }
    __syncthreads();
}

#ifndef PHMASK
#define PHMASK 0x3FF
#endif
#ifndef NLAYER
#define NLAYER 2
#endif
#ifndef DUPMASK
#define DUPMASK 0
#endif
struct Args { const float* in[18]; float* out; unsigned char* ws; };
typedef __attribute__((address_space(4))) const Args CArgs;
__device__ __forceinline__ CArgs* kargs() { CArgs* p = (CArgs*)__builtin_amdgcn_kernarg_segment_ptr(); asm volatile("" : "+s"(p)); return p; }
#define PHASE_PROLOG() CArgs* ka = kargs(); unsigned char* ws = ka->ws; (void)ws; const int tid = opaque_tid(), lane = tid & 63, wave = __builtin_amdgcn_readfirstlane(tid >> 6), gw = vcu * NWAVES + wave; (void)lane; (void)gw
__global__ void __launch_bounds__(NWAVES * 64, 2) fwd_kernel(Args args_unused) {
    extern __shared__ __attribute__((aligned(16))) unsigned char lds_raw[];
    LAS unsigned char* lds = (LAS unsigned char*)lds_raw;
    volatile LAS unsigned* MISC = (volatile LAS unsigned*)(lds + MISC_OFF);
#define G ((int)gridDim.x)
#define bx ((int)blockIdx.x)
#define vcu ((G % 8 == 0) ? (bx % 8) * (G / 8) + bx / 8 : bx)
#define NGW (G * NWAVES)
    for (int u = threadIdx.x; u < (LDS_BYTES - LDSCTL_OFF) / 4; u += NWAVES * 64) ((LAS unsigned*)(lds + LDSCTL_OFF))[u] = 0u;
    __syncthreads();
    (void)xcd_barrier_post((unsigned*)(args_unused.ws + WS_CTL) + CW_BAR, MISC + 8);
#define GRID_BARRIER() do { XcdBarrier b_; b_.bar = (unsigned*)(kargs()->ws + WS_CTL) + CW_BAR; b_.x = xb_xcc_id(); b_.st = (volatile LAS unsigned*)(lds + MISC_OFF) + 8; xcd_barrier(b_); } while (0)

    _Pragma("nounroll") for (int layer = 0; layer < NLAYER; ++layer) {
        if (layer == 0) {
            { PHASE_PROLOG();
              for (int ll = 0; ll < NLAYER; ++ll) { CV_PTRS(P, ka, ws, ll); unsigned* cmi = (unsigned*)(ws + WS_CMAXI) + (size_t)ll * NIN;
                  for (int it = gw; it < 64 * 24; it += NGW) { const int kb = it / 24, cb = it % 24, n0 = cb < 8 ? 256 * cb : (cb < 16 ? COL_RV + 256 * (cb - 8) : COL_AV + 256 * (cb - 16)); colmax_wide(P.w_in, NIN, P.g_mix, 64 * kb, n0, cmi, lane); } }
              const float* x0 = ka->in[0]; const float* x1 = ka->in[1]; pg8::u64_t* SS = (pg8::u64_t*)(ws + WS_SS); bf16* XB = (bf16*)(ws + WS_U); signed char* XQ = (signed char*)(ws + WS_XQ); float* RA = (float*)(ws + WS_RA);
              for (int m = gw; m < M; m += NGW) x_row_in(m < 8192 ? x0 + (size_t)m * D : x1 + (size_t)(m - 8192) * D, XB + (size_t)m * D, SS + m, XQ + (size_t)m * D, RA + m, lane); }
            GRID_BARRIER();
        }
        {
            PHASE_PROLOG();
            bf16* Pbf = (bf16*)(ws + WS_PBF);
            LAS float* scr = (LAS float*)(lds + wave * TR_SCR);
            { CV_PTRS(P, ka, ws, layer);
              for (int it = gw; it < CV_A; it += NGW) convert_item(P, it, scr, lane);
              unsigned* cm = (unsigned*)(ws + WS_CMAX) + (size_t)layer * NGU;
              { constexpr int NB = DFF / 256, NI = 64 * NB;
                for (int it = gw; it < 2 * NI; it += NGW) { const int r = it < NI ? it : it - NI; const int kb = r / NB, n0 = 256 * (r % NB);
                    colmax_wide(it < NI ? P.w_gate : P.w_up, DFF, P.g_ffn, 64 * kb, n0, cm + (it < NI ? 0 : DFF), lane); } }
              unsigned* cmp_ = (unsigned*)(ws + WS_CMAXP) + (size_t)layer * D;
              for (int it = gw; it < 64 * (D / 256); it += NGW) { const int kb = it / (D / 256), n0 = 256 * (it % (D / 256)); colmax_wide(P.w_pg, D, P.g_ple, 64 * kb, n0, cmp_, lane); } }
            { const float* pp0 = ka->in[2] + (size_t)layer * 8192 * PLE; const float* pp1 = ka->in[3] + (size_t)layer * 8192 * PLE;
              for (int i = bx * 512 + tid; i < M * PLE / 4; i += G * 512) { const int e = 4 * i; const float* src = e < 8192 * PLE ? pp0 + e : pp1 + (e - 8192 * PLE);
                  const f32x4 v = __builtin_nontemporal_load((const GAS f32x4*)src); v2u o; o.x = pk2(v.x, v.y); o.y = pk2(v.z, v.w); *(GAS v2u*)(Pbf + e) = o; } }
            if (layer > 0) { const bf16* XBs = (const bf16*)(ws + WS_XB2); signed char* XQ = (signed char*)(ws + WS_XQ); float* RA = (float*)(ws + WS_RA);
                quant_pass(XBs, XQ, RA, gw, NGW, lane); }
        }
        GRID_BARRIER();
        { CArgs* ka = kargs(); unsigned char* ws = ka->ws; pg8::Gemm g{(bf16*)(ws + WS_XQ), (bf16*)(ws + WS_WINQ), M, NQI, D / 2}; pg8::StaticOrder S; S.init(M, NQI, G, bx);
          pg8::EpiStoreHeadsQ E{(bf16*)(ws + WS_Z), M, (const float*)(ws + WS_RA), (const float*)(ws + WS_DBI)};
          pg8::gemm_phase<pg8::EpiStoreHeadsQ, pg8::StaticOrder, true, true, true>(lds, g, S, E); }
        { CArgs* ka = kargs(); unsigned char* ws = ka->ws; pg8::Gemm g{(bf16*)(ws + (layer == 0 ? WS_U : WS_XB2)), (bf16*)(ws + WS_WIN), M, NIN - NQI, D}; pg8::StaticOrder S; S.init(M, NIN - NQI, G, bx);
          pg8::EpiStoreHeads E{(bf16*)(ws + WS_Z), M, (const pg8::u64_t*)(ws + WS_SS) + (size_t)(layer * 3 + 0) * M, ka->in[8] + (size_t)layer * HD, ka->in[9] + (size_t)layer * HD, (LAS float*)(lds + 131072)};
          pg8::gemm_phase<pg8::EpiStoreHeads, pg8::StaticOrder, true, true>(lds, g, S, E); }
        GRID_BARRIER();
        for (int rep = 0; rep < ((DUPMASK & 8) ? 2 : 1); ++rep)
        for (int item = bx; item < 128 + 128; item += G) {
            PHASE_PROLOG();
            const bf16* Z = (const bf16*)(ws + WS_Z); bf16* MIX = (bf16*)(ws + WS_MIX);
            if (item < 128) retention_item(lds, Z, (bf16*)(ws + WS_YF), MIX, ka->in[6] + (size_t)layer * 2 * NH, ka->in[7] + (size_t)layer * 2048, (unsigned long long*)(ws + WS_EXP), (unsigned*)(ws + WS_CTL) + CW_FLAG + 4096 * layer, item, tid);
            else attention_item(lds, Z, (bf16*)(ws + WS_OP), (float*)(ws + WS_LP), MIX, ka->in[8] + (size_t)layer * HD, ka->in[9] + (size_t)layer * HD, item - 128, tid);
        }
        {
            PHASE_PROLOG();
            LAS float* scr = (LAS float*)(lds + wave * TR_SCR);
            unsigned* qhead = (unsigned*)(ws + WS_CTL) + CW_QUEUE + 64 * layer;
            CV_PTRS(P, ka, ws, layer);
            volatile LAS unsigned* qb = (volatile LAS unsigned*)(lds + MISC_OFF) + 2;
            for (;;) {
                __syncthreads();
                if (tid == 0) *qb = atomicAdd(qhead, 32u);
                __syncthreads();
                const int it0 = CV_A + (int)__builtin_amdgcn_readfirstlane(*qb);
                if (it0 >= CV_ALL) break;
                for (int k = 0; k < 4; ++k) { const int it = it0 + 8 * k + wave; if (it < CV_ALL) convert_item(P, it, scr, lane); }
            }
        }
        GRID_BARRIER();
        { CArgs* ka = kargs(); unsigned char* ws = ka->ws; pg8::Gemm g{(bf16*)(ws + WS_MIX), (bf16*)(ws + WS_WOUT), M, D, D}; pg8::StaticOrder S; S.init(M, D, G, bx);
          pg8::EpiResAdd E{(bf16*)(ws + (layer == 0 ? WS_U : WS_XB2)), D};
          pg8::gemm_phase<pg8::EpiResAdd, pg8::StaticOrder, true, true>(lds, g, S, E); }
        GRID_BARRIER();
        { PHASE_PROLOG(); const bf16* XBs = (const bf16*)(ws + (layer == 0 ? WS_U : WS_XB2)); signed char* XQ = (signed char*)(ws + WS_XQ); float* RA = (float*)(ws + WS_RA);
          quant_pass(XBs, XQ, RA, gw, NGW, lane); }
        GRID_BARRIER();
        for (int rep = 0; rep < ((DUPMASK & 64) ? 2 : 1); ++rep)
        { CArgs* ka = kargs(); unsigned char* ws = ka->ws; pg8::Gemm g{(bf16*)(ws + WS_XQ), (bf16*)(ws + WS_WGU), M, NGU, D / 2}; pg8::StaticOrder S; S.init(M, NGU, G, bx);
          pg8::EpiSwiGLUQ E{(bf16*)(ws + WS_Z), DFF, (const float*)(ws + WS_RA), (const float*)(ws + WS_DB)};
          pg8::gemm_phase<pg8::EpiSwiGLUQ, pg8::StaticOrder, true, true, true>(lds, g, S, E); }
        { constexpr int NU_F = (M / 256) * (NGU / 256); const int heavy = NU_F % G;
          { CArgs* ka = kargs(); unsigned char* ws = ka->ws; int Kp = PLE; asm volatile("" : "+s"(Kp)); pg8::Gemm g{(bf16*)(ws + WS_PBF), (bf16*)(ws + WS_WPP), M, D, Kp}; pg8::StaticOrder S; pg8::EpiStoreBf16 E{(bf16*)(ws + WS_PP), D};
            if (heavy > 0 && heavy < G) { const int npp = (M / 256) * (D / 256), cut = (npp * 3 / 4) / (G - heavy) * (G - heavy);
                if (bx >= heavy) { S.init(M, D, G - heavy, bx - heavy); S.lim = cut; } else { S.init(M, D, heavy, bx); S.base = cut; } }
            else S.init(M, D, G, bx);
            pg8::gemm_phase<pg8::EpiStoreBf16, pg8::StaticOrder, true, true>(lds, g, S, E); } }
        GRID_BARRIER();
        { CArgs* ka = kargs(); unsigned char* ws = ka->ws; pg8::Gemm g{(bf16*)(ws + WS_Z), (bf16*)(ws + WS_WDN), M, D, DFF}; pg8::StaticOrder S; S.init(M, D, G, bx); S.tr = 1;
          pg8::EpiResAdd E{(bf16*)(ws + (layer == 0 ? WS_U : WS_XB2)), D};
          pg8::gemm_phase<pg8::EpiResAdd, pg8::StaticOrder, true, true>(lds, g, S, E); }
        GRID_BARRIER();
        { PHASE_PROLOG(); const bf16* XBs = (const bf16*)(ws + (layer == 0 ? WS_U : WS_XB2)); signed char* XQ = (signed char*)(ws + WS_XQ); float* RA = (float*)(ws + WS_RA);
          quant_pass(XBs, XQ, RA, gw, NGW, lane); }
        GRID_BARRIER();
        if (PHMASK & 256)
        { CArgs* ka = kargs(); unsigned char* ws = ka->ws; const bf16* sb = (const bf16*)(ws + (layer == 0 ? WS_U : WS_XB2)); pg8::Gemm g{(bf16*)(ws + WS_XQ), (bf16*)(ws + WS_WPG), M, D, D / 2}; pg8::StaticOrder S; S.init(M, D, G, bx);
          pg8::EpiPleT<true> E{sb, (const bf16*)(ws + WS_PP), (bf16*)(ws + WS_XB2), nullptr, (const float*)(ws + WS_RA), (const float*)(ws + WS_DBP), (pg8::u64_t*)(ws + WS_SS) + (size_t)((layer * 3 + 3) % 6) * M, layer == NLAYER - 1 ? ka->out : nullptr, D};
          pg8::gemm_phase<pg8::EpiPleT<true>, pg8::StaticOrder, true, true, true>(lds, g, S, E); }
        GRID_BARRIER();
    }
}

#undef G
#undef bx
#undef vcu
#undef NGW
#undef GRID_BARRIER
extern "C" void kernel_launch(void* const* d_in, const int* in_sizes, int n_in, void* d_out, int out_size, void* d_ws, size_t ws_size, hipStream_t stream) {
    static int grid = 0;
    if (grid == 0) {
        if (n_in != 18 || out_size != M * D || ws_size < WS_END) { fprintf(stderr, "kernel_launch: unexpected shapes: n_in %d out %d ws %zu (need %zu)\n", n_in, out_size, ws_size, (size_t)WS_END); grid = -1; return; }
        int dev = 0, cus = 0, per_cu = 0;
        if (hipGetDevice(&dev) != hipSuccess || hipDeviceGetAttribute(&cus, hipDeviceAttributeMultiprocessorCount, dev) != hipSuccess) { grid = -1; return; }
        if (hipFuncSetAttribute((const void*)fwd_kernel, hipFuncAttributeMaxDynamicSharedMemorySize, LDS_BYTES) != hipSuccess) { fprintf(stderr, "kernel_launch: hipFuncSetAttribute failed\n"); grid = -1; return; }
        if (hipOccupancyMaxActiveBlocksPerMultiprocessor(&per_cu, (const void*)fwd_kernel, NWAVES * 64, LDS_BYTES) != hipSuccess || per_cu < 1) fprintf(stderr, "kernel_launch: occupancy query says %d\n", per_cu);
        (void)hipGetLastError();
        grid = cus;
    }
    if (grid < 0) return;
    if (hipMemsetAsync((char*)d_ws + WS_CTL, 0, CTL_ZERO_BYTES, stream) != hipSuccess) return;
    Args a{};
    for (int i = 0; i < 18; ++i) a.in[i] = (const float*)d_in[i];
    a.out = (float*)d_out; a.ws = (unsigned char*)d_ws;
    hipLaunchKernelGGL(fwd_kernel, dim3(grid), dim3(NWAVES * 64), LDS_BYTES, stream, a);
}
```
